# Optimizing an MI355X kernel written in HIP

```python
import math
import jax, jax.numpy as jnp
from jax import lax
import numpy as np

D_MODEL = 1024
BATCH = 8
SEQ = 4096
DEPTH = 4

HEAD_DIM = 64
NSA_HEADS = 8
NSA_GROUPS = 2
CMP_BLOCK = 32
CMP_STRIDE = 16
CMP_HIDDEN = 256
SEL_BLOCK = 64
SEL_TOPK = 8
NSA_WINDOW = 512
SWA_HEADS = 8
SWA_GROUPS = 2
SWA_WINDOW = 128
FOX_HEADS = 8
FOX_GATE_BIAS = 3.0
Q_BLOCK = 128
REL_BUCKETS = 32
REL_MAX_DIST = 128
D_FF = 2816
N_BRANCH = 3
LN_EPS = 1e-5
DN_ALPHA = (2 * DEPTH) ** 0.25
DN_BETA = (8 * DEPTH) ** -0.25

W_A = NSA_HEADS * HEAD_DIM
KV_A = NSA_GROUPS * HEAD_DIM
W_B = SWA_HEADS * HEAD_DIM
KV_B = SWA_GROUPS * HEAD_DIM
W_C = FOX_HEADS * HEAD_DIM
D_IN = W_A + 6 * KV_A + 3 * NSA_HEADS + W_B + 2 * KV_B + 3 * W_C + FOX_HEADS

kernel_name = 'hybrid_nsa_swa_sink_fox_macaron_deepnorm'


def _layer_norm(x, g, b):
    xf = x.astype(jnp.float32)
    mu = jnp.mean(xf, axis=-1, keepdims=True)
    var = jnp.mean(jnp.square(xf - mu), axis=-1, keepdims=True)
    return ((xf - mu) * lax.rsqrt(var + LN_EPS) * g + b).astype(x.dtype)


def _swiglu(x, w1, w2):
    gt, up = jnp.split(x @ w1, 2, axis=-1)
    return (jax.nn.silu(gt) * up) @ w2


def _t5_bucket(dist):
    n = jnp.maximum(dist, 0)
    exact = REL_BUCKETS // 2
    log_ratio = jnp.log(jnp.maximum(n, 1).astype(jnp.float32) / exact) / math.log(REL_MAX_DIST / exact)
    large = exact + (log_ratio * (REL_BUCKETS - exact)).astype(jnp.int32)
    return jnp.where(n < exact, n, jnp.minimum(large, REL_BUCKETS - 1))


def _masked_softmax(logits, mask):
    logits = jnp.where(mask, logits.astype(jnp.float32), -jnp.inf)
    m = jnp.max(logits, axis=-1, keepdims=True)
    m = jnp.where(jnp.isfinite(m), m, 0.0)
    p = jnp.exp(logits - m)
    return p / jnp.maximum(jnp.sum(p, axis=-1, keepdims=True), 1e-30)


def _split_cols(z):
    sizes = [W_A, 6 * KV_A, 3 * NSA_HEADS, W_B, KV_B, KV_B, W_C, W_C, W_C, FOX_HEADS]
    return jnp.split(z, np.cumsum(sizes)[:-1].tolist(), axis=-1)


def _compress(z, pe, w1, w2):
    B, S, G, dh = z.shape
    r = CMP_BLOCK // CMP_STRIDE
    n_chunk = S // CMP_STRIDE
    nc = n_chunk - r + 1
    zr = z.reshape(B, n_chunk, CMP_STRIDE, G, dh)
    blocks = jnp.concatenate([zr[:, j:j + nc] for j in range(r)], axis=2)
    blocks = blocks + pe[:, None, :]
    flat = blocks.transpose(0, 3, 1, 2, 4).reshape(B, G, nc, CMP_BLOCK * dh)
    return jax.nn.gelu(flat @ w1) @ w2


def _nsa(q_a, kv_a, g_a, pe_k, pe_v, ck_w1, ck_w2, cv_w1, cv_w2, rel_a):
    B, S, _ = q_a.shape
    G, HPG, dh = NSA_GROUPS, NSA_HEADS // NSA_GROUPS, HEAD_DIM
    nb = S // Q_BLOCK
    scale = HEAD_DIM ** -0.5
    q = q_a.reshape(B, S, G, HPG, dh).transpose(0, 2, 3, 1, 4)
    k_cmp, v_cmp, k_slc, v_slc, k_win, v_win = [z.reshape(B, S, G, dh) for z in jnp.split(kv_a, 6, axis=-1)]
    kc = _compress(k_cmp, pe_k, ck_w1, ck_w2)
    vc = _compress(v_cmp, pe_v, cv_w1, cv_w2)
    nc = kc.shape[2]
    ns = S // SEL_BLOCK
    n_sel = min(SEL_TOPK, ns)
    ks = k_slc.reshape(B, ns, SEL_BLOCK, G, dh).transpose(0, 3, 1, 2, 4)
    vs = v_slc.reshape(B, ns, SEL_BLOCK, G, dh).transpose(0, 3, 1, 2, 4)
    pad = ((0, 0), (0, 0), (NSA_WINDOW, 0), (0, 0))
    kw = jnp.pad(k_win.transpose(0, 2, 1, 3), pad)
    vw = jnp.pad(v_win.transpose(0, 2, 1, 3), pad)
    gates = jax.nn.sigmoid(g_a.astype(jnp.float32)).reshape(B, S, G, HPG, 3).transpose(0, 2, 3, 1, 4)
    rel_g = rel_a.reshape(G, HPG, REL_BUCKETS)
    c_start = jnp.arange(nc) * CMP_STRIDE
    c_end = c_start + (CMP_BLOCK - 1)
    s_start = jnp.arange(ns) * SEL_BLOCK
    overlap = ((c_start[:, None] < s_start[None] + SEL_BLOCK) & (c_end[:, None] >= s_start[None])).astype(jnp.float32)
    i_w = jnp.arange(Q_BLOCK)
    j_w = jnp.arange(Q_BLOCK + NSA_WINDOW)
    dist_w = NSA_WINDOW + i_w[:, None] - j_w[None]
    band_w = (dist_w >= 0) & (dist_w < NSA_WINDOW)
    bias_w = rel_g[:, :, _t5_bucket(dist_w)]
    blk = jnp.arange(ns)
    sel_off = jnp.arange(SEL_BLOCK)
    gather = jax.vmap(jax.vmap(lambda kb, ix: kb[ix]))
    lookup = jax.vmap(lambda tab, bk: jnp.moveaxis(tab[:, bk], 0, 1), in_axes=(0, 1), out_axes=1)

    def block(qb):
        q0 = qb * Q_BLOCK
        t = q0 + jnp.arange(Q_BLOCK)
        qq = lax.dynamic_slice_in_dim(q, q0, Q_BLOCK, axis=3)
        gg = lax.dynamic_slice_in_dim(gates, q0, Q_BLOCK, axis=3)
        s_c = jnp.einsum('bghqd,bgkd->bghqk', qq, kc, preferred_element_type=jnp.float32) * scale
        s_c = s_c + rel_g[:, :, _t5_bucket(t[:, None] - c_end[None])]
        p_c = _masked_softmax(s_c, c_end[None] <= t[:, None])
        o_c = jnp.einsum('bghqk,bgkd->bghqd', p_c.astype(vc.dtype), vc)
        imp = jnp.einsum('bghqk,kj->bgqj', p_c, overlap)
        cur = (t // SEL_BLOCK)[:, None]
        forced = (blk[None] == 0) | (blk[None] == cur) | (blk[None] == cur - 1)
        valid = blk[None] * SEL_BLOCK <= t[:, None]
        score = jnp.where(forced, jnp.inf, jnp.where(valid, imp, -jnp.inf))
        _, idx = lax.top_k(score, n_sel)
        k_sel = gather(ks, idx).reshape(B, G, Q_BLOCK, n_sel * SEL_BLOCK, dh)
        v_sel = gather(vs, idx).reshape(B, G, Q_BLOCK, n_sel * SEL_BLOCK, dh)
        pos = (idx[..., None] * SEL_BLOCK + sel_off).reshape(B, G, Q_BLOCK, n_sel * SEL_BLOCK)
        dist = t[:, None] - pos
        s_s = jnp.einsum('bghqd,bgqkd->bghqk', qq, k_sel, preferred_element_type=jnp.float32) * scale
        s_s = s_s + lookup(rel_g, _t5_bucket(dist))
        p_s = _masked_softmax(s_s, (dist >= 0)[:, :, None])
        o_s = jnp.einsum('bghqk,bgqkd->bghqd', p_s.astype(v_sel.dtype), v_sel)
        kwb = lax.dynamic_slice_in_dim(kw, q0, Q_BLOCK + NSA_WINDOW, axis=2)
        vwb = lax.dynamic_slice_in_dim(vw, q0, Q_BLOCK + NSA_WINDOW, axis=2)
        s_w = jnp.einsum('bghqd,bgkd->bghqk', qq, kwb, preferred_element_type=jnp.float32) * scale + bias_w
        mask_w = band_w & ((q0 - NSA_WINDOW + j_w) >= 0)[None]
        p_w = _masked_softmax(s_w, mask_w)
        o_w = jnp.einsum('bghqk,bgkd->bghqd', p_w.astype(vwb.dtype), vwb)
        return gg[..., 0:1] * o_c + gg[..., 1:2] * o_s + gg[..., 2:3] * o_w

    out = lax.map(block, jnp.arange(nb))
    return out.transpose(1, 0, 4, 2, 3, 5).reshape(B, S, W_A).astype(q_a.dtype)


def _swa_sink(q_b, k_b, v_b, sinks, rel_b):
    B, S, _ = q_b.shape
    G, HPG, dh, W = SWA_GROUPS, SWA_HEADS // SWA_GROUPS, HEAD_DIM, SWA_WINDOW
    nb = S // W
    scale = HEAD_DIM ** -0.5
    q = q_b.reshape(B, nb, W, G, HPG, dh)
    k = k_b.reshape(B, nb, W, G, dh)
    v = v_b.reshape(B, nb, W, G, dh)

    def with_prev(z):
        prev = jnp.pad(z[:, :-1], ((0, 0), (1, 0), (0, 0), (0, 0), (0, 0)))
        return jnp.concatenate([prev, z], axis=2)

    kk, vv = with_prev(k), with_prev(v)
    i = jnp.arange(W)
    j = jnp.arange(2 * W)
    dist = W + i[:, None] - j[None]
    band = (dist >= 0) & (dist < W)
    first = (jnp.arange(nb)[:, None] * W - W + j[None]) >= 0
    mask = band[None] & first[:, None, :]
    bias = rel_b.reshape(G, HPG, REL_BUCKETS)[:, :, _t5_bucket(dist)]
    logits = jnp.einsum('bnqghd,bnkgd->bghnqk', q, kk, preferred_element_type=jnp.float32) * scale
    logits = jnp.where(mask, logits + bias[:, :, None], -jnp.inf)
    sink = jnp.broadcast_to(sinks.astype(jnp.float32).reshape(1, G, HPG, 1, 1, 1), logits.shape[:-1] + (1,))
    p = jax.nn.softmax(jnp.concatenate([logits, sink], axis=-1), axis=-1)[..., :-1]
    o = jnp.einsum('bghnqk,bnkgd->bnqghd', p.astype(vv.dtype), vv)
    return o.reshape(B, S, W_B)


def _fox(q_c, k_c, v_c, f_c, b_f):
    B, S, _ = q_c.shape
    H, dh = FOX_HEADS, HEAD_DIM
    nb = S // Q_BLOCK
    scale = HEAD_DIM ** -0.5
    q = q_c.reshape(B, S, H, dh).transpose(0, 2, 1, 3)
    k = k_c.reshape(B, S, H, dh).transpose(0, 2, 1, 3)
    v = v_c.reshape(B, S, H, dh).transpose(0, 2, 1, 3)
    log_f = jax.nn.log_sigmoid((f_c + b_f).astype(jnp.float32))
    c = jnp.cumsum(log_f, axis=1).transpose(0, 2, 1)
    s_idx = jnp.arange(S)

    def block(qb):
        q0 = qb * Q_BLOCK
        t = q0 + jnp.arange(Q_BLOCK)
        qq = lax.dynamic_slice_in_dim(q, q0, Q_BLOCK, axis=2)
        cq = lax.dynamic_slice_in_dim(c, q0, Q_BLOCK, axis=2)
        logits = jnp.einsum('bhqd,bhkd->bhqk', qq, k, preferred_element_type=jnp.float32) * scale
        logits = logits + cq[..., None] - c[:, :, None, :]
        logits = jnp.where(s_idx[None] <= t[:, None], logits, -jnp.inf)
        p = jax.nn.softmax(logits, axis=-1)
        return jnp.einsum('bhqk,bhkd->bhqd', p.astype(v.dtype), v)

    out = lax.map(block, jnp.arange(nb))
    return out.transpose(1, 0, 3, 2, 4).reshape(B, S, W_C)


def _token_mix(h, w_in, pe_k, pe_v, ck_w1, ck_w2, cv_w1, cv_w2, sinks, b_f, rel_bias,
               w_br_a, w_br_b, w_br_c, w_gate, b_gate, w_out):
    B, S, D = h.shape
    q_a, kv_a, g_a, q_b, k_b, v_b, q_c, k_c, v_c, f_c = _split_cols(h @ w_in)
    rel_t = rel_bias.T
    o_a = _nsa(q_a, kv_a, g_a, pe_k, pe_v, ck_w1, ck_w2, cv_w1, cv_w2, rel_t[:NSA_HEADS])
    o_b = _swa_sink(q_b, k_b, v_b, sinks, rel_t[NSA_HEADS:])
    o_c = _fox(q_c, k_c, v_c, f_c, b_f)
    g = jax.nn.sigmoid(h @ w_gate + b_gate).reshape(B, S, N_BRANCH, D)
    merged = g[:, :, 0] * (o_a @ w_br_a) + g[:, :, 1] * (o_b @ w_br_b) + g[:, :, 2] * (o_c @ w_br_c)
    return merged @ w_out


def setup_inputs(seed: int = 0) -> dict:
    key = jax.random.key(seed)
    keys = iter(jax.random.split(key, 32))
    L, D, F = DEPTH, D_MODEL, D_FF

    def nrm(shape, scale):
        return jax.random.normal(next(keys), shape, jnp.float32) * scale

    return {
        'x': nrm((BATCH, SEQ, D), 1.0),
        'rel_bias': nrm((REL_BUCKETS, NSA_HEADS + SWA_HEADS), 0.5),
        'ln1_g': 1.0 + nrm((L, D), 0.02),
        'ln1_b': nrm((L, D), 0.02),
        'ffn1_w1': nrm((L, D, 2 * F), D ** -0.5),
        'ffn1_w2': nrm((L, F, D), DN_BETA * F ** -0.5),
        'w_in': nrm((L, D, D_IN), D ** -0.5),
        'cmp_pe_k': nrm((L, CMP_BLOCK, HEAD_DIM), 0.1),
        'cmp_pe_v': nrm((L, CMP_BLOCK, HEAD_DIM), 0.1),
        'cmp_k_w1': nrm((L, CMP_BLOCK * HEAD_DIM, CMP_HIDDEN), (CMP_BLOCK * HEAD_DIM) ** -0.5),
        'cmp_k_w2': nrm((L, CMP_HIDDEN, HEAD_DIM), CMP_HIDDEN ** -0.5),
        'cmp_v_w1': nrm((L, CMP_BLOCK * HEAD_DIM, CMP_HIDDEN), (CMP_BLOCK * HEAD_DIM) ** -0.5),
        'cmp_v_w2': nrm((L, CMP_HIDDEN, HEAD_DIM), CMP_HIDDEN ** -0.5),
        'swa_sinks': nrm((L, SWA_HEADS), 1.0),
        'fox_b_f': FOX_GATE_BIAS + nrm((L, FOX_HEADS), 0.1),
        'w_br_a': nrm((L, W_A, D), W_A ** -0.5),
        'w_br_b': nrm((L, W_B, D), W_B ** -0.5),
        'w_br_c': nrm((L, W_C, D), W_C ** -0.5),
        'w_gate': nrm((L, D, N_BRANCH * D), D ** -0.5),
        'b_gate': nrm((L, N_BRANCH * D), 0.01),
        'w_out': nrm((L, D, D), DN_BETA * D ** -0.5),
        'ln2_g': 1.0 + nrm((L, D), 0.02),
        'ln2_b': nrm((L, D), 0.02),
        'ffn2_w1': nrm((L, D, 2 * F), D ** -0.5),
        'ffn2_w2': nrm((L, F, D), DN_BETA * F ** -0.5),
        'ln3_g': 1.0 + nrm((L, D), 0.02),
        'ln3_b': nrm((L, D), 0.02),
    }


def reference(x, rel_bias, ln1_g, ln1_b, ffn1_w1, ffn1_w2, w_in, cmp_pe_k, cmp_pe_v,
              cmp_k_w1, cmp_k_w2, cmp_v_w1, cmp_v_w2, swa_sinks, fox_b_f,
              w_br_a, w_br_b, w_br_c, w_gate, b_gate, w_out, ln2_g, ln2_b,
              ffn2_w1, ffn2_w2, ln3_g, ln3_b):
    for l in range(DEPTH):
        x = _layer_norm(DN_ALPHA * x + 0.5 * _swiglu(x, ffn1_w1[l], ffn1_w2[l]), ln1_g[l], ln1_b[l])
        mix = _token_mix(x, w_in[l], cmp_pe_k[l], cmp_pe_v[l], cmp_k_w1[l], cmp_k_w2[l],
                         cmp_v_w1[l], cmp_v_w2[l], swa_sinks[l], fox_b_f[l], rel_bias,
                         w_br_a[l], w_br_b[l], w_br_c[l], w_gate[l], b_gate[l], w_out[l])
        x = _layer_norm(DN_ALPHA * x + mix, ln2_g[l], ln2_b[l])
        x = _layer_norm(DN_ALPHA * x + 0.5 * _swiglu(x, ffn2_w1[l], ffn2_w2[l]), ln3_g[l], ln3_b[l])
    return x
```

```cpp
#include <hip/hip_runtime.h>
#include <hip/hip_cooperative_groups.h>
#include <cstdio>
#include <cstdint>
namespace cg = cooperative_groups;
__device__ __forceinline__ int otid() { int t = threadIdx.x; asm volatile("" : "+v"(t)); return t; }
__device__ __forceinline__ int obid() { int t = blockIdx.x; asm volatile("" : "+s"(t)); return t; }
#ifndef PROBE_ST7N
#define PROBE_ST7N 1
#endif
namespace pg8 {
#define PG8_LAS __attribute__((address_space(3)))
typedef unsigned short bf16_t;
typedef short bf16x8 __attribute__((ext_vector_type(8)));
typedef float f32x4 __attribute__((ext_vector_type(4)));
typedef unsigned u32x4 __attribute__((ext_vector_type(4)));
constexpr int BM = 256, BK = 64, HALF = 128, HTB = HALF * BK * 2  , STAGE_BYTES = 8 * HTB, NXCD = 8, WGM = 8;

__host__ __device__ __forceinline__ int lds_byte(int r, int c) { const int st = (r >> 4) * 2 + (c >> 5), rr = r & 15, cc = c & 31, ob = rr * 64 + cc * 2; return st * 1024 + (ob ^ (((ob >> 9) & 1) << 5)); }
__host__ __device__ __forceinline__ void stage_rc(int b, int& R, int& C) { const int st = b / 1024, sb = b % 1024, swz = sb ^ (((sb >> 9) & 1) << 5); R = (st >> 1) * 16 + swz / 64; C = (st & 1) * 32 + (swz % 64) / 2; }
__host__ __device__ __forceinline__ int perm32(int rho) { const int n = rho >> 4, i = rho & 15; return 8 * (i >> 2) + 4 * n + (i & 3); }

struct Unit { int pm, pn; };
struct Gemm { const bf16_t* A; const bf16_t* Bt; int M, N, K; };

struct StaticOrder {
    int nM, nN, nwg, G, c;
    __host__ __device__ void init(int M, int N, int G_, int c_) { nM = M / BM; nN = N / BM; nwg = nM * nN; G = G_; c = c_; }
    __host__ __device__ bool next(int i, Unit& u) const {
        const long L = (long)i * G + c; if (L >= nwg) return false;
        int wgid = (int)L; { const int q = nwg / NXCD, r = nwg % NXCD, xcd = wgid % NXCD, off = wgid / NXCD; wgid = (xcd < r ? xcd * (q + 1) : r * (q + 1) + (xcd - r) * q) + off; }
        const int nig = WGM * nN, gid = wgid / nig, fm = gid * WGM, gsz = (nM - fm) < WGM ? (nM - fm) : WGM;
        u.pm = fm + ((wgid % nig) % gsz); u.pn = (wgid % nig) / gsz; return true;
    }
    __device__ __forceinline__ void a_ready(const Unit&) const {}
    __device__ __forceinline__ void done(const Unit&) const {}
};

__device__ __forceinline__ unsigned cvt_pk_bf16(float lo, float hi) { unsigned r; asm volatile("v_cvt_pk_bf16_f32 %0, %1, %2" : "=v"(r) : "v"(lo), "v"(hi)); return r; }
typedef float f32x2 __attribute__((ext_vector_type(2)));
__device__ __forceinline__ f32x2 gelu_pk(f32x2 v) {
    const f32x2 av = __builtin_elementwise_abs(v), d = av * 0.2316418882f + 1.0f;
    f32x2 t; t.x = __builtin_amdgcn_rcpf(d.x); t.y = __builtin_amdgcn_rcpf(d.y);
    f32x2 q = t * 0.5307027145f + (-0.7265760135f); q = q * t + 0.7107068705f; q = q * t + (-0.142248368f); q = q * t + 0.127414796f; q = q * t;
    const f32x2 s = (v * v) * (-0.72134752044f);
    f32x2 e; e.x = __builtin_amdgcn_exp2f(s.x); e.y = __builtin_amdgcn_exp2f(s.y);
    const f32x2 m = v * (q * e), r = v - m;
    f32x2 o; o.x = v.x < 0.f ? m.x : r.x; o.y = v.y < 0.f ? m.y : r.y; return o;
}

template <int ACT  > struct EpiBf16 {
    static constexpr bool PERM = true, AFTER_DRAIN = false; static_assert(ACT == 0 || ACT == 1, "EpiBf16: ACT is 0 (none) or 1 (gelu_pk)");
    bf16_t* O; int ldc; const float* bias; int split_cols; size_t split_stride; float scale0;
    __device__ __forceinline__ void operator()(const f32x4 (&acc)[2][2][4][2], const Unit& u, int wr, int wc, int fr, int fq) const {
        const int row0 = u.pm * BM + wr * 64 + fr; int colt = u.pn * BM; bf16_t* base = O;
        float sc = 1.f; if (split_cols) { const int t = colt / split_cols; base += (size_t)t * split_stride; colt -= t * split_cols; if (t == 0) sc = scale0; }
        const int col0 = colt + wc * 32 + 8 * fq, bcol0 = u.pn * BM + wc * 32 + 8 * fq;
        f32x4 bv[2][2];
#pragma unroll
        for (int bj = 0; bj < 2; ++bj)
#pragma unroll
            for (int n = 0; n < 2; ++n) bv[bj][n] = bias ? *(const f32x4*)(bias + bcol0 + bj * HALF + 4 * n) : (f32x4){0.f, 0.f, 0.f, 0.f};
#pragma unroll
        for (int ai = 0; ai < 2; ++ai)
#pragma unroll
            for (int m = 0; m < 4; ++m) { bf16_t* rowp = base + (size_t)(row0 + ai * HALF + m * 16) * ldc + col0;
#pragma unroll
                for (int bj = 0; bj < 2; ++bj) { f32x4 v0 = acc[ai][bj][m][0] + bv[bj][0], v1 = acc[ai][bj][m][1] + bv[bj][1];
                    if (ACT == 1) { f32x2 a = gelu_pk((f32x2){v0[0], v0[1]}), b = gelu_pk((f32x2){v0[2], v0[3]}), c = gelu_pk((f32x2){v1[0], v1[1]}), d = gelu_pk((f32x2){v1[2], v1[3]});
                        v0 = (f32x4){a.x, a.y, b.x, b.y}; v1 = (f32x4){c.x, c.y, d.x, d.y}; }
                    v0 = v0 * sc; v1 = v1 * sc; u32x4 w; w.x = cvt_pk_bf16(v0[0], v0[1]); w.y = cvt_pk_bf16(v0[2], v0[3]); w.z = cvt_pk_bf16(v1[0], v1[1]); w.w = cvt_pk_bf16(v1[2], v1[3]);
                    *(u32x4*)(rowp + bj * HALF) = w; } }
    }
};
template <class Epi, class Sched, bool ALIGN_EPI = false, bool SP2 = false>
__device__ __forceinline__ void gemm_phase(PG8_LAS unsigned char* lds, const Gemm g, const Sched& S, const Epi& E) {
    const int tid = otid(), wid = __builtin_amdgcn_readfirstlane(tid >> 6), lane = tid & 63, wr = wid >> 2, wc = wid & 3, fr = lane & 15, fq = lane >> 4;
    const int K = g.K, nt = K / BK;
    unsigned voffA[2], voffB[2];
#pragma unroll
    for (int i = 0; i < 2; ++i) { int R, C; stage_rc(tid * 16 + i * 8192, R, C); const int Rb = Epi::PERM ? ((R & ~31) + perm32(R & 31)) : R;
        voffA[i] = (unsigned)(R * K + C) * 2u; voffB[i] = (unsigned)(Rb * K + C) * 2u; }
    const size_t kstep = (size_t)(BK * 2);
    const size_t hstep = (size_t)HALF * K * 2;
    const size_t tstep = 2 * hstep;
    const unsigned ldsw = (unsigned)wid * 1024u;
    const int aoff = lds_byte(wr * 64 + fr, fq * 8), boff = lds_byte(wc * 32 + fr, fq * 8);
#define PG8_SA(b, h) (((b) * 2 + (h)) * HTB)
#define PG8_SB(b, h) ((4 + (b) * 2 + (h)) * HTB)
#define PG8_STAGE(bufoff, gbase, voff) do { _Pragma("unroll") for (int _i = 0; _i < 2; ++_i) \
        __builtin_amdgcn_global_load_lds((const unsigned*)((const char*)(gbase) + (voff)[_i]), (PG8_LAS unsigned*)(lds + (bufoff) + ldsw + _i * 8192), 16, 0, 0); } while (0)
#define PG8_LDA(dst, b, h) do { _Pragma("unroll") for (int m = 0; m < 4; ++m) _Pragma("unroll") for (int k = 0; k < 2; ++k) dst[m][k] = *(const PG8_LAS bf16x8*)(lds + PG8_SA(b, h) + aoff + m * 2048 + k * 1024); } while (0)
#define PG8_LDB(dst, b, h) do { _Pragma("unroll") for (int n = 0; n < 2; ++n) _Pragma("unroll") for (int k = 0; k < 2; ++k) dst[n][k] = *(const PG8_LAS bf16x8*)(lds + PG8_SB(b, h) + boff + n * 2048 + k * 1024); } while (0)
#define PG8_MMA(ai, bj, At, Bt) do { __builtin_amdgcn_s_setprio(1); _Pragma("unroll") for (int m = 0; m < 4; ++m) _Pragma("unroll") for (int n = 0; n < 2; ++n) _Pragma("unroll") for (int k = 0; k < 2; ++k) \
        acc[ai][bj][m][n] = __builtin_amdgcn_mfma_f32_16x16x32_bf16(Bt[n][k], At[m][k], acc[ai][bj][m][n], 0, 0, 0); __builtin_amdgcn_s_setprio(0); } while (0)
#define PG8_WAIT_V(n) asm volatile("s_waitcnt vmcnt(" #n ")" ::: "memory")
#define PG8_WAIT_L(n) asm volatile("s_waitcnt lgkmcnt(" #n ")" ::: "memory")
#define PG8_BAR __builtin_amdgcn_s_barrier()
#define PG8_SCHED __builtin_amdgcn_sched_barrier(0)
    Unit cur, nxt; int ui = 0;
    if (!S.next(0, cur)) return;
    f32x4 acc[2][2][4][2];
#pragma unroll
    for (int a = 0; a < 2; ++a)
#pragma unroll
        for (int b = 0; b < 2; ++b)
#pragma unroll
            for (int m = 0; m < 4; ++m)
#pragma unroll
                for (int n = 0; n < 2; ++n) acc[a][b][m][n] = (f32x4){0.f, 0.f, 0.f, 0.f};
    bf16x8 At[4][2], B0[2][2], B1[2][2];
    const char* cA = (const char*)g.A + (size_t)cur.pm * tstep; const char* cB = (const char*)g.Bt + (size_t)cur.pn * tstep;
    S.a_ready(cur);
    if constexpr (SP2) {
        PG8_STAGE(PG8_SB(0, 0), cB, voffB); PG8_STAGE(PG8_SB(0, 1), cB + hstep, voffB); PG8_STAGE(PG8_SA(0, 0), cA, voffA); PG8_STAGE(PG8_SA(0, 1), cA + hstep, voffA);
        if (wr == 1) PG8_BAR;
        PG8_WAIT_V(2); PG8_BAR;
        PG8_STAGE(PG8_SB(1, 0), cB + kstep, voffB); PG8_STAGE(PG8_SA(1, 0), cA + kstep, voffA); PG8_STAGE(PG8_SB(1, 1), cB + hstep + kstep, voffB);
        PG8_WAIT_V(6); PG8_BAR;
    } else {
        PG8_STAGE(PG8_SB(0, 0), cB, voffB); PG8_STAGE(PG8_SA(0, 0), cA, voffA); PG8_STAGE(PG8_SB(0, 1), cB + hstep, voffB); PG8_STAGE(PG8_SA(0, 1), cA + hstep, voffA);
        if (wr == 1) PG8_BAR;
        PG8_WAIT_V(4); PG8_BAR;
        PG8_STAGE(PG8_SB(1, 0), cB + kstep, voffB); PG8_STAGE(PG8_SA(1, 0), cA + kstep, voffA); PG8_STAGE(PG8_SB(1, 1), cB + hstep + kstep, voffB);
        PG8_WAIT_V(6); PG8_BAR;
    }
    for (;;) {
        const bool has_next = S.next(ui + 1, nxt);
        const char* nA = has_next ? (const char*)g.A + (size_t)nxt.pm * tstep : cA; const char* nB = has_next ? (const char*)g.Bt + (size_t)nxt.pn * tstep : cB;
        for (int t = 0; t < nt; t += 2) {
            const bool last = (t == nt - 2);
            const char* a1 = cA + (size_t)(t + 1) * kstep;
            const char* a2 = last ? nA : cA + (size_t)(t + 2) * kstep; const char* b2 = last ? nB : cB + (size_t)(t + 2) * kstep;
            const char* a3 = a2 + kstep; const char* b3 = b2 + kstep;
            if (last && has_next) S.a_ready(nxt);
            if constexpr (SP2) {
            PG8_LDB(B0, 0, 0); PG8_LDB(B1, 0, 1); PG8_SCHED; PG8_LDA(At, 0, 0); PG8_STAGE(PG8_SA(1, 1), a1 + hstep, voffA);
            PG8_WAIT_V(8); PG8_WAIT_L(0); PG8_BAR; PG8_MMA(0, 0, At, B0); PG8_MMA(0, 1, At, B1); PG8_BAR; PG8_SCHED;
            PG8_LDA(At, 0, 1); PG8_STAGE(PG8_SB(0, 0), b2, voffB); PG8_STAGE(PG8_SB(0, 1), b2 + hstep, voffB); PG8_STAGE(PG8_SA(0, 0), a2, voffA);
            PG8_WAIT_V(8); PG8_WAIT_L(0); PG8_BAR; PG8_MMA(1, 0, At, B0); PG8_MMA(1, 1, At, B1); PG8_BAR; PG8_SCHED;
            PG8_LDB(B0, 1, 0); PG8_LDB(B1, 1, 1); PG8_SCHED; PG8_LDA(At, 1, 0); PG8_STAGE(PG8_SA(0, 1), a2 + hstep, voffA);
            PG8_WAIT_V(8); PG8_WAIT_L(0); PG8_BAR; PG8_MMA(0, 0, At, B0); PG8_MMA(0, 1, At, B1); PG8_BAR; PG8_SCHED;
            PG8_LDA(At, 1, 1); PG8_STAGE(PG8_SB(1, 0), b3, voffB); PG8_STAGE(PG8_SB(1, 1), b3 + hstep, voffB); PG8_STAGE(PG8_SA(1, 0), a3, voffA);
            PG8_WAIT_V(8); PG8_WAIT_L(0); PG8_BAR; PG8_MMA(1, 0, At, B0); PG8_MMA(1, 1, At, B1); PG8_BAR; PG8_SCHED;
            } else {
            PG8_LDB(B0, 0, 0); PG8_SCHED; PG8_LDA(At, 0, 0); PG8_STAGE(PG8_SA(1, 1), a1 + hstep, voffA);
            PG8_WAIT_L(8); PG8_BAR; PG8_WAIT_L(0); PG8_MMA(0, 0, At, B0); PG8_BAR; PG8_SCHED;
            PG8_LDB(B1, 0, 1); PG8_STAGE(PG8_SB(0, 0), b2, voffB);
            PG8_BAR; PG8_WAIT_L(0); PG8_MMA(0, 1, At, B1); PG8_BAR;
            PG8_LDA(At, 0, 1); PG8_STAGE(PG8_SA(0, 0), a2, voffA);
            PG8_BAR; PG8_WAIT_L(0); PG8_MMA(1, 0, At, B0); PG8_BAR; PG8_SCHED;
            PG8_STAGE(PG8_SB(0, 1), b2 + hstep, voffB);
            PG8_WAIT_V(6); PG8_BAR; PG8_MMA(1, 1, At, B1); PG8_BAR;
            PG8_LDB(B0, 1, 0); PG8_SCHED; PG8_LDA(At, 1, 0); PG8_STAGE(PG8_SA(0, 1), a2 + hstep, voffA);
            PG8_WAIT_L(8); PG8_BAR; PG8_WAIT_L(0); PG8_MMA(0, 0, At, B0); PG8_BAR; PG8_SCHED;
            PG8_LDB(B1, 1, 1); PG8_STAGE(PG8_SB(1, 0), b3, voffB);
            PG8_BAR; PG8_WAIT_L(0); PG8_MMA(0, 1, At, B1); PG8_BAR;
            PG8_LDA(At, 1, 1); PG8_STAGE(PG8_SA(1, 0), a3, voffA);
            PG8_BAR; PG8_WAIT_L(0); PG8_MMA(1, 0, At, B0); PG8_BAR; PG8_SCHED;
            PG8_STAGE(PG8_SB(1, 1), b3 + hstep, voffB);
            PG8_WAIT_V(6); PG8_BAR; PG8_MMA(1, 1, At, B1); PG8_BAR;
            }
        }
        if constexpr (ALIGN_EPI) { if (wr == 0) PG8_BAR; }
        if constexpr (!Epi::AFTER_DRAIN) { E(acc, cur, wr, wc, fr, fq); S.done(cur); }
        if (!has_next) break;
#pragma unroll
        for (int a = 0; a < 2; ++a)
#pragma unroll
            for (int b = 0; b < 2; ++b)
#pragma unroll
                for (int m = 0; m < 4; ++m)
#pragma unroll
                    for (int n = 0; n < 2; ++n) acc[a][b][m][n] = (f32x4){0.f, 0.f, 0.f, 0.f};
        cur = nxt; cA = nA; cB = nB; ++ui;
        if constexpr (ALIGN_EPI) { if (wr == 1) PG8_BAR; }
    }
    PG8_WAIT_V(0);
    if constexpr (!ALIGN_EPI) { if (wr == 0) PG8_BAR; }
    PG8_BAR;
    if constexpr (Epi::AFTER_DRAIN) { E.fused(acc, cur, wr, wc, fr, fq, lds, wid, lane); S.done(cur); }
#undef PG8_SA
#undef PG8_SB
#undef PG8_STAGE
#undef PG8_LDA
#undef PG8_LDB
#undef PG8_MMA
#undef PG8_WAIT_V
#undef PG8_WAIT_L
#undef PG8_BAR
#undef PG8_SCHED
}
}
namespace mk {
using pg8::bf16_t; using pg8::bf16x8; using pg8::f32x4; using pg8::u32x4; using pg8::Unit;
#define LAS __attribute__((address_space(3)))
typedef LAS unsigned char* lptr;
typedef float f32x16 __attribute__((ext_vector_type(16)));
typedef short s16x4 __attribute__((ext_vector_type(4)));
typedef unsigned u32x2 __attribute__((ext_vector_type(2)));
template <class T> __device__ __forceinline__ T lds_ld(lptr p) { return *(const LAS T*)p; }
template <class T> __device__ __forceinline__ void lds_st(lptr p, T v) { *(LAS T*)p = v; }

constexpr int BATCH = 8, SEQ = 4096, DM = 1024, DEPTH = 4, M = BATCH * SEQ, DFF = 2816, ZLD = 3616, NT = 512;
constexpr int C_QA = 0, C_KCMP = 512, C_VCMP = 640, C_KSLC = 768, C_VSLC = 896, C_KWIN = 1024, C_VWIN = 1152, C_GA = 1280, C_QB = 1304, C_KB = 1816, C_VB = 1944,
              C_QC = 2072, C_KC = 2584, C_VC = 3096, C_FC = 3608;
constexpr float ALPHA = 1.6817928305074290f, LOG2E = 1.4426950408889634f, LN_EPS = 1e-5f;
constexpr size_t MiB = 1u << 20;
constexpr size_t W_1A = 0, W_2A = W_1A + 11534336, W_Z = W_2A + 5767168, W_G = W_Z + 7864320, W_BR = W_G + 6291456, W_O = W_BR + 3145728, W_1B = W_O + 2097152,
                 W_2B = W_1B + 11534336, W_C1 = W_2B + 5767168, W_C2 = W_C1 + 2097152, W_PEB = W_C2 + 65536, W_END = W_PEB + 65536;
static_assert(W_END <= 54 * MiB, "weights region");
constexpr size_t WS_XN = 54 * MiB, WS_BIG = 118 * MiB, WS_GATE = WS_BIG, WS_MRG = WS_XN, WS_OA = 344 * MiB, WS_OB = 376 * MiB, WS_OC = 408 * MiB,
                 WS_KC = 440 * MiB, WS_CUM = 441 * MiB, WS_BAR = 442 * MiB, WS_STATS = 443 * MiB, WS_TOTAL = 444 * MiB;
static_assert((size_t)M * ZLD * 2 <= 226 * MiB, "Z fits");
constexpr int LDS_BYTES = 144 * 1024;
constexpr int A_KT = 0, A_VT = 18432, A_CB = 43008, A_SCORE = 43520, A_SELM = 59904, A_STASH = 60416, A_TAB = 93184, A_XB = 140000, KP = 144, VP = 192;

struct Params { const float* in[27]; float* out; unsigned char* ws; };

typedef float f32x2_t __attribute__((ext_vector_type(2))); typedef __bf16 bf16x2_t __attribute__((ext_vector_type(2)));
__device__ __forceinline__ unsigned cvt_pk(float lo, float hi) { f32x2_t v = {lo, hi}; bf16x2_t b = __builtin_convertvector(v, bf16x2_t); return __builtin_bit_cast(unsigned, b); }
__device__ __forceinline__ float bf2f(bf16_t v) { return __uint_as_float((unsigned)v << 16); }
__device__ __forceinline__ float ex2(float x) { return __builtin_amdgcn_exp2f(x); }
__device__ __forceinline__ float sigmoidf_(float x) { return __builtin_amdgcn_rcpf(1.0f + ex2(-x * LOG2E)); }
__device__ __forceinline__ f32x16 mfma32(bf16x8 a, bf16x8 b, f32x16 c) { return __builtin_amdgcn_mfma_f32_32x32x16_bf16(a, b, c, 0, 0, 0); }
__device__ __forceinline__ float wave_sum(float v) {
#pragma unroll
    for (int o = 1; o < 64; o <<= 1) v += __shfl_xor(v, o);
    return v;
}

struct EpiSwiGLU {
    static constexpr bool PERM = true, AFTER_DRAIN = false; bf16_t* H;
    __device__ __forceinline__ void operator()(const f32x4 (&acc)[2][2][4][2], const Unit& u, int wr, int wc, int fr, int fq) const {
        const int row0 = u.pm * 256 + wr * 64 + fr, col0 = u.pn * 128 + wc * 32 + 8 * fq;
#pragma unroll
        for (int ai = 0; ai < 2; ++ai)
#pragma unroll
            for (int m = 0; m < 4; ++m) {
                bf16_t* rowp = H + (size_t)(row0 + ai * 128 + m * 16) * DFF + col0;
                float h[8];
#pragma unroll
                for (int n = 0; n < 2; ++n)
#pragma unroll
                    for (int e = 0; e < 4; ++e) { const float g = acc[ai][0][m][n][e], up = acc[ai][1][m][n][e]; h[n * 4 + e] = g * sigmoidf_(g) * up; }
                u32x4 w; w.x = cvt_pk(h[0], h[1]); w.y = cvt_pk(h[2], h[3]); w.z = cvt_pk(h[4], h[5]); w.w = cvt_pk(h[6], h[7]);
                *(u32x4*)rowp = w;
            }
    }
};
struct EpiResid {
    static constexpr bool PERM = true, AFTER_DRAIN = false; float* X; const float* stats; const float* lng; const float* lnb; float ca, cb;
    __device__ __forceinline__ void operator()(const f32x4 (&acc)[2][2][4][2], const Unit& u, int wr, int wc, int fr, int fq) const {
        const int row0 = u.pm * 256 + wr * 64 + fr, col0 = u.pn * 256 + wc * 32 + 8 * fq;
#pragma unroll
        for (int bj = 0; bj < 2; ++bj) {
            const int c = col0 + bj * 128;
            f32x4 g0 = {1.f, 1.f, 1.f, 1.f}, g1 = g0, b0 = {0.f, 0.f, 0.f, 0.f}, b1 = b0;
            if (lng) { g0 = *(const f32x4*)(lng + c); g1 = *(const f32x4*)(lng + c + 4); b0 = *(const f32x4*)(lnb + c); b1 = *(const f32x4*)(lnb + c + 4); }
            g0 = g0 * ca; g1 = g1 * ca; b0 = b0 * ca; b1 = b1 * ca;
#pragma unroll
            for (int ai = 0; ai < 2; ++ai)
#pragma unroll
                for (int m = 0; m < 4; ++m) {
                    const int row = row0 + ai * 128 + m * 16;
                    float mean = 0.f, rstd = 1.f;
                    if (lng) { const float2 st = *(const float2*)(stats + 2 * (size_t)row); mean = st.x; rstd = st.y; }
                    float* p = X + (size_t)row * DM + c;
                    f32x4 x0 = *(const f32x4*)p, x1 = *(const f32x4*)(p + 4);
                    x0 = (x0 - mean) * rstd * g0 + b0 + acc[ai][bj][m][0] * cb; x1 = (x1 - mean) * rstd * g1 + b1 + acc[ai][bj][m][1] * cb;
                    *(f32x4*)p = x0; *(f32x4*)(p + 4) = x1;
                    if (m & 1) asm volatile("" ::: "memory");
                }
        }
    }
};
struct EpiZ {
    static constexpr bool PERM = true, AFTER_DRAIN = false; bf16_t* Z;
    __device__ __forceinline__ void operator()(const f32x4 (&acc)[2][2][4][2], const Unit& u, int wr, int wc, int fr, int fq) const {
        const int row0 = u.pm * 256 + wr * 64 + fr, col0 = u.pn * 256 + wc * 32 + 8 * fq;
#pragma unroll
        for (int ai = 0; ai < 2; ++ai)
#pragma unroll
            for (int m = 0; m < 4; ++m)
#pragma unroll
                for (int bj = 0; bj < 2; ++bj) {
                    const int c = col0 + bj * 128;
                    if (c < ZLD) {
                        const f32x4 v0 = acc[ai][bj][m][0], v1 = acc[ai][bj][m][1];
                        u32x4 w; w.x = cvt_pk(v0[0], v0[1]); w.y = cvt_pk(v0[2], v0[3]); w.z = cvt_pk(v1[0], v1[1]); w.w = cvt_pk(v1[2], v1[3]);
                        *(u32x4*)(Z + (size_t)(row0 + ai * 128 + m * 16) * ZLD + c) = w;
                    }
                }
    }
};
struct EpiGate {
    static constexpr bool PERM = true, AFTER_DRAIN = false; bf16_t* G; const float* bias;
    __device__ __forceinline__ void operator()(const f32x4 (&acc)[2][2][4][2], const Unit& u, int wr, int wc, int fr, int fq) const {
        const int row0 = u.pm * 256 + wr * 64 + fr, col0 = u.pn * 256 + wc * 32 + 8 * fq;
#pragma unroll
        for (int bj = 0; bj < 2; ++bj) {
            const int c = col0 + bj * 128;
            const f32x4 b0 = *(const f32x4*)(bias + c), b1 = *(const f32x4*)(bias + c + 4);
#pragma unroll
            for (int ai = 0; ai < 2; ++ai)
#pragma unroll
                for (int m = 0; m < 4; ++m) {
                    const f32x4 v0 = acc[ai][bj][m][0] + b0, v1 = acc[ai][bj][m][1] + b1;
                    u32x4 w; w.x = cvt_pk(sigmoidf_(v0[0]), sigmoidf_(v0[1])); w.y = cvt_pk(sigmoidf_(v0[2]), sigmoidf_(v0[3]));
                    w.z = cvt_pk(sigmoidf_(v1[0]), sigmoidf_(v1[1])); w.w = cvt_pk(sigmoidf_(v1[2]), sigmoidf_(v1[3]));
                    *(u32x4*)(G + (size_t)(row0 + ai * 128 + m * 16) * (3 * DM) + c) = w;
                }
        }
    }
};
struct EpiMerge {
    static constexpr bool PERM = true, AFTER_DRAIN = false; const bf16_t* G; bf16_t* Mg;
    __device__ __forceinline__ void operator()(const f32x4 (&acc)[2][2][4][2], const Unit& u, int wr, int wc, int fr, int fq) const {
        const int br = u.pn >> 2, pm = u.pm - 128 * br, pn = u.pn & 3;
        if (br) asm volatile("s_waitcnt vmcnt(0)" ::: "memory");
        const int row0 = pm * 256 + wr * 64 + fr, col0 = pn * 256 + wc * 32 + 8 * fq;
#pragma unroll
        for (int ai = 0; ai < 2; ++ai)
#pragma unroll
            for (int m = 0; m < 4; ++m)
#pragma unroll
                for (int bj = 0; bj < 2; ++bj) {
                    const size_t row = (size_t)(row0 + ai * 128 + m * 16); const int c = col0 + bj * 128;
                    const u32x4 gw = *(const u32x4*)(G + row * (3 * DM) + br * DM + c);
                    float v[8];
#pragma unroll
                    for (int j = 0; j < 4; ++j) {
                        v[2 * j] = __uint_as_float(gw[j] << 16) * acc[ai][bj][m][j >> 1][(2 * j) & 3];
                        v[2 * j + 1] = __uint_as_float(gw[j] & 0xffff0000u) * acc[ai][bj][m][j >> 1][(2 * j + 1) & 3];
                    }
                    if (br) {
                        const u32x4 mw = *(const u32x4*)(Mg + row * DM + c);
#pragma unroll
                        for (int j = 0; j < 4; ++j) { v[2 * j] += __uint_as_float(mw[j] << 16); v[2 * j + 1] += __uint_as_float(mw[j] & 0xffff0000u); }
                    }
                    u32x4 w; w.x = cvt_pk(v[0], v[1]); w.y = cvt_pk(v[2], v[3]); w.z = cvt_pk(v[4], v[5]); w.w = cvt_pk(v[6], v[7]);
                    *(u32x4*)(Mg + row * DM + c) = w;
                }
    }
};
struct MergeOrder {
    pg8::StaticOrder base;
    __device__ __forceinline__ bool next(int i, Unit& u) const { Unit t; if (!base.next(i / 3, t)) return false; const int br = i % 3; u.pm = t.pm + 128 * br; u.pn = t.pn + 4 * br; return true; }
    __device__ __forceinline__ void a_ready(const Unit&) const {}
    __device__ __forceinline__ void done(const Unit&) const {}
};
#define XB_TMO      128
#define XB_XCNT(j)  (256  + 64 * (j))
#define XB_XSUB(j)  (1280 + 64 * (j))
#define XB_XGEN(j)  (2304 + 64 * (j))
#define XB_TOP      3328
#define XB_TOPGEN   3392
#define XCD_BAR_WORDS 3456
#define XB_SPIN_CAP (1u << 18)

__device__ __forceinline__ unsigned xb_ld(unsigned* p)              { return __hip_atomic_load(p, __ATOMIC_RELAXED, __HIP_MEMORY_SCOPE_AGENT); }
__device__ __forceinline__ unsigned xb_add(unsigned* p, unsigned v) { return __hip_atomic_fetch_add(p, v, __ATOMIC_RELAXED, __HIP_MEMORY_SCOPE_AGENT); }
__device__ __forceinline__ unsigned xb_xcc_id() { return (unsigned)__builtin_amdgcn_s_getreg((3 << 11) | 20) & 0xFu; }
#define XB_SPIN(cond, bar) do { unsigned _sp = 0; while (cond) { __builtin_amdgcn_s_sleep(1); \
    if ((++_sp & 255u) == 0u) { if (xb_ld(&(bar)[XB_TMO])) break; if (_sp > XB_SPIN_CAP) { atomicAdd(&(bar)[XB_TMO], 1u); break; } } } } while (0)

struct XcdBarrier {
    unsigned* bar; unsigned x;
    volatile LAS unsigned* st;
};

__device__ __forceinline__ XcdBarrier xcd_barrier_post(unsigned* bar, volatile LAS unsigned* st) {
    XcdBarrier b; b.bar = bar; b.x = xb_xcc_id(); b.st = st;
    if (threadIdx.x == 0) (void)xb_add(&bar[XB_XCNT(b.x)], 1u);
    return b;
}
__device__ __forceinline__ void xcd_barrier_complete(unsigned* bar, unsigned x, unsigned& nloc, unsigned& nx) {
    const unsigned G = gridDim.x * gridDim.y * gridDim.z;
    unsigned sum, cnt, mine, sp = 0u;
    for (;;) {
        sum = 0u; cnt = 0u; mine = 0u;
#pragma unroll
        for (unsigned j = 0; j < 16; ++j) { const unsigned c = xb_ld(&bar[XB_XCNT(j)]); sum += c; cnt += (c > 0u) ? 1u : 0u; mine = (j == x) ? c : mine; }
        if (sum == G) break;
        __builtin_amdgcn_s_sleep(1);
        if ((++sp & 255u) == 0u) { if (xb_ld(&bar[XB_TMO])) break; if (sp > XB_SPIN_CAP) { atomicAdd(&bar[XB_TMO], 1u); break; } }
    }
    nloc = mine > 0u ? mine : 1u; nx = cnt > 0u ? cnt : 1u;
}

__device__ __forceinline__ void xcd_barrier(const XcdBarrier& b) {
    asm volatile("s_waitcnt vmcnt(0)" ::: "memory");
    __syncthreads();
    if (threadIdx.x == 0) {
        unsigned* bar = b.bar;
        __builtin_amdgcn_s_waitcnt(0);
        unsigned nloc = b.st[0], nx = b.st[1];
        if (nloc == 0u) { xcd_barrier_complete(bar, b.x, nloc, nx); b.st[0] = nloc; b.st[1] = nx; }
        const unsigned old = xb_add(&bar[XB_XSUB(b.x)], 1u);
        const unsigned gen = old / nloc;
        if (old + 1u == (gen + 1u) * nloc) {
            __builtin_amdgcn_fence(__ATOMIC_RELEASE, "agent");
            asm volatile("s_waitcnt vmcnt(0)" ::: "memory");
            const unsigned og = xb_add(&bar[XB_TOP], 1u);
            const unsigned tg = og / nx;
            if (og + 1u == (tg + 1u) * nx) xb_add(&bar[XB_TOPGEN], 1u);
            else XB_SPIN(xb_ld(&bar[XB_TOPGEN]) == tg, bar);
            __builtin_amdgcn_fence(__ATOMIC_ACQUIRE, "agent");
            xb_add(&bar[XB_XGEN(b.x)], 1u);
            asm volatile("s_waitcnt vmcnt(0)" ::: "memory");
        } else {
            XB_SPIN(xb_ld(&bar[XB_XGEN(b.x)]) == gen, bar);
            __builtin_amdgcn_fence(__ATOMIC_ACQUIRE, "agent");
            asm volatile("s_waitcnt vmcnt(0)" ::: "memory");
        }
    }
    __syncthreads();
}

__device__ __forceinline__ void tr_item(const float* W, int ldw, int K, int k0, int n0, bf16_t* WT, int drow0, lptr scr, int lane) {
    f32x4 tv[8];
#pragma unroll
    for (int i = 0; i < 8; ++i) tv[i] = *(const f32x4*)(W + (size_t)(k0 + 8 * i + (lane >> 3)) * ldw + n0 + 4 * (lane & 7));
#pragma unroll
    for (int i = 0; i < 8; ++i) {
        const lptr d_ = scr + ((8 * i + (lane >> 3)) * 33 + 4 * (lane & 7)) * 4;
        lds_st<float>(d_, tv[i][0]); lds_st<float>(d_ + 4, tv[i][1]); lds_st<float>(d_ + 8, tv[i][2]); lds_st<float>(d_ + 12, tv[i][3]);
    }
    const int c = lane & 7;
#pragma unroll
    for (int j = 0; j < 4; ++j) {
        const int n = (lane >> 3) + 8 * j; const lptr s = scr + ((8 * c) * 33 + n) * 4;
        u32x4 o; o.x = cvt_pk(lds_ld<float>(s), lds_ld<float>(s + 33 * 4)); o.y = cvt_pk(lds_ld<float>(s + 2 * 33 * 4), lds_ld<float>(s + 3 * 33 * 4));
        o.z = cvt_pk(lds_ld<float>(s + 4 * 33 * 4), lds_ld<float>(s + 5 * 33 * 4)); o.w = cvt_pk(lds_ld<float>(s + 6 * 33 * 4), lds_ld<float>(s + 7 * 33 * 4));
        *(u32x4*)(WT + (size_t)(drow0 + n) * K + k0 + 8 * c) = o;
    }
}
__device__ __forceinline__ void prep_weights(lptr L, const Params& P, int l) {
    const int tid = otid(), lane = tid & 63, wave = tid >> 6;
    const int gw = blockIdx.x * 8 + wave, NGW = gridDim.x * 8;
    const lptr scr = L + wave * 8704;
    unsigned char* ws = P.ws;
#pragma unroll 1
    for (int mi = 0; mi < 14; ++mi) {
        const float* W; int K, N, mode = 0; bf16_t* WT;
        switch (mi) {
            case 0: W = P.in[4] + (size_t)l * DM * 2 * DFF; K = DM; N = 2 * DFF; WT = (bf16_t*)(ws + W_1A); mode = 1; break;
            case 1: W = P.in[5] + (size_t)l * DFF * DM; K = DFF; N = DM; WT = (bf16_t*)(ws + W_2A); break;
            case 2: W = P.in[6] + (size_t)l * DM * ZLD; K = DM; N = ZLD; WT = (bf16_t*)(ws + W_Z); break;
            case 3: W = P.in[18] + (size_t)l * DM * 3 * DM; K = DM; N = 3 * DM; WT = (bf16_t*)(ws + W_G); break;
            case 4: W = P.in[15] + (size_t)l * 512 * DM; K = 512; N = DM; WT = (bf16_t*)(ws + W_BR); break;
            case 5: W = P.in[16] + (size_t)l * 512 * DM; K = 512; N = DM; WT = (bf16_t*)(ws + W_BR) + 1 * DM * 512; break;
            case 6: W = P.in[17] + (size_t)l * 512 * DM; K = 512; N = DM; WT = (bf16_t*)(ws + W_BR) + 2 * DM * 512; break;
            case 7: W = P.in[20] + (size_t)l * DM * DM; K = DM; N = DM; WT = (bf16_t*)(ws + W_O); break;
            case 8: W = P.in[23] + (size_t)l * DM * 2 * DFF; K = DM; N = 2 * DFF; WT = (bf16_t*)(ws + W_1B); mode = 1; break;
            case 9: W = P.in[24] + (size_t)l * DFF * DM; K = DFF; N = DM; WT = (bf16_t*)(ws + W_2B); break;
            case 10: W = P.in[9] + (size_t)l * 2048 * 256; K = 2048; N = 256; WT = (bf16_t*)(ws + W_C1); break;
            case 11: W = P.in[11] + (size_t)l * 2048 * 256; K = 2048; N = 256; WT = (bf16_t*)(ws + W_C1) + 256 * 2048; break;
            case 12: W = P.in[10] + (size_t)l * 256 * 64; K = 256; N = 64; WT = (bf16_t*)(ws + W_C2); break;
            default: W = P.in[12] + (size_t)l * 256 * 64; K = 256; N = 64; WT = (bf16_t*)(ws + W_C2) + 64 * 256; break;
        }
        const int nblk = N / 32, nitems = (K / 64) * nblk;
        for (int it = gw; it < nitems; it += NGW) {
            const int kb = it / nblk, nb = it - kb * nblk, n0 = 32 * nb;
            int drow0 = n0;
            if (mode == 1) { const int up = n0 >= DFF, nn = up ? n0 - DFF : n0; drow0 = 256 * (nn >> 7) + (up ? 128 : 0) + (nn & 127); }
            tr_item(W, N, K, 64 * kb, n0, WT, drow0, scr, lane);
        }
    }
    if (blockIdx.x < 32) {
        const int src = blockIdx.x >> 4, part = (blockIdx.x & 15) * 2 + (tid >> 8), n = tid & 255;
        const float* pe = (src ? P.in[8] : P.in[7]) + (size_t)l * 2048; const float* w1 = (src ? P.in[11] : P.in[9]) + (size_t)l * 2048 * 256;
        float s = 0.f;
        for (int k = 64 * part; k < 64 * part + 64; ++k) s += pe[k] * w1[(size_t)k * 256 + n];
        ((float*)(ws + W_PEB))[(src * 32 + part) * 256 + n] = s;
    }
}
__device__ __forceinline__ void prep_x(const Params& P) {
    const size_t n4 = (size_t)M * DM / 4; const f32x4* xi = (const f32x4*)P.in[0]; f32x4* xo = (f32x4*)P.out; u32x2* xn = (u32x2*)(P.ws + WS_XN);
    for (size_t i = (size_t)obid() * NT + otid(); i < n4; i += (size_t)gridDim.x * NT) {
        const f32x4 v = xi[i]; xo[i] = v; u32x2 w; w.x = cvt_pk(v[0], v[1]); w.y = cvt_pk(v[2], v[3]); xn[i] = w;
    }
}
__device__ __forceinline__ void ln_pass(const Params& P, const float* g, const float* b, const bool write_x) {
    const int tid_ = otid(); const int lane = tid_ & 63, wave = tid_ >> 6;
    const int gw = blockIdx.x * 8 + wave, NGW = gridDim.x * 8;
    f32x4 gv[4], bv[4];
#pragma unroll
    for (int j = 0; j < 4; ++j) { gv[j] = ((const f32x4*)g)[lane + 64 * j]; bv[j] = ((const f32x4*)b)[lane + 64 * j]; }
    float* stats = (float*)(P.ws + WS_STATS);
    for (int r0 = gw * 4; r0 < M; r0 += NGW * 4) {
        f32x4 v[4][4];
#pragma unroll
        for (int q = 0; q < 4; ++q) {
            const f32x4* xr = (const f32x4*)(P.out + (size_t)(r0 + q) * DM) + lane;
#pragma unroll
            for (int j = 0; j < 4; ++j) v[q][j] = xr[64 * j];
        }
#pragma unroll
        for (int q = 0; q < 4; ++q) {
            float s = 0.f;
#pragma unroll
            for (int j = 0; j < 4; ++j) s += (v[q][j][0] + v[q][j][1]) + (v[q][j][2] + v[q][j][3]);
            const float mean = wave_sum(s) * (1.f / DM); float s2 = 0.f;
#pragma unroll
            for (int j = 0; j < 4; ++j) { v[q][j] = v[q][j] - mean; s2 += (v[q][j][0] * v[q][j][0] + v[q][j][1] * v[q][j][1]) + (v[q][j][2] * v[q][j][2] + v[q][j][3] * v[q][j][3]); }
            const float rstd = 1.f / sqrtf(wave_sum(s2) * (1.f / DM) + LN_EPS);
            if (lane == 0) { float2 st; st.x = mean; st.y = rstd; *(float2*)(stats + 2 * (size_t)(r0 + q)) = st; }
            f32x4* xw = (f32x4*)(P.out + (size_t)(r0 + q) * DM) + lane;
            u32x2* o8 = (u32x2*)((bf16_t*)(P.ws + WS_XN) + (size_t)(r0 + q) * DM) + lane;
#pragma unroll
            for (int j = 0; j < 4; ++j) {
                const f32x4 y = v[q][j] * rstd * gv[j] + bv[j];
                if (write_x) xw[64 * j] = y;
                u32x2 w; w.x = cvt_pk(y[0], y[1]); w.y = cvt_pk(y[2], y[3]); o8[64 * j] = w;
            }
        }
    }
}
__device__ __forceinline__ float gelu_tanh(float x) {
    const float u = 0.7978845608028654f * (x + 0.044715f * x * x * x);
    const float t = ex2(2.f * LOG2E * u);
    return 0.5f * x * (2.f - 2.f * __builtin_amdgcn_rcpf(t + 1.f));
}
__device__ __forceinline__ float log_sigmoid(float x) { return x >= 0.f ? -log1pf(__expf(-x)) : x - log1pf(__expf(x)); }
__device__ __forceinline__ void compress_phase(lptr L, const Params& P, int l) {
    const int tid = otid(), lane = tid & 63, wave = tid >> 6, n = lane & 31, hl = lane >> 5;
    unsigned char* ws = P.ws; const bf16_t* Z = (const bf16_t*)(ws + WS_BIG);
    constexpr int HP = 264;
    for (int u = blockIdx.x; u < 256; u += gridDim.x) {
        const int src = u >> 7, bg = (u >> 3) & 15, rt = u & 7, b = bg >> 1, g = bg & 1, i0 = 32 * rt;
        const int coff = (src ? C_VCMP : C_KCMP) + g * 64;
        const bf16_t* Zb = Z + (size_t)b * SEQ * ZLD + coff + 8 * hl;
        const bf16_t* B1 = (const bf16_t*)(ws + W_C1) + (size_t)src * 256 * 2048 + (size_t)(32 * wave + n) * 2048 + 8 * hl;
        f32x16 acc = {};
        const int tok0 = 16 * (i0 + n);
#pragma unroll 2
        for (int p = 0; p < 32; ++p) {
            int tok = tok0 + p; tok = tok > SEQ - 1 ? SEQ - 1 : tok;
            const bf16_t* ar = Zb + (size_t)tok * ZLD; const bf16_t* br = B1 + p * 64;
#pragma unroll
            for (int s = 0; s < 4; ++s) acc = mfma32(*(const bf16x8*)(ar + 16 * s), *(const bf16x8*)(br + 16 * s), acc);
        }
        float peb = 0.f;
        { const float* pp = (const float*)(ws + W_PEB) + src * 32 * 256 + 32 * wave + n;
#pragma unroll 8
          for (int q = 0; q < 32; ++q) peb += pp[q * 256]; }
#pragma unroll
        for (int r = 0; r < 16; ++r) {
            const int row = 8 * (r >> 2) + 4 * hl + (r & 3);
            const float hv = gelu_tanh(acc[r] + peb);
            lds_st<bf16_t>(L + (row * HP + 32 * wave + n) * 2, (bf16_t)(cvt_pk(hv, 0.f) & 0xffffu));
        }
        __syncthreads();
        if (wave < 2) {
            const bf16_t* B2 = (const bf16_t*)(ws + W_C2) + (size_t)src * 64 * 256 + (size_t)(32 * wave + n) * 256 + 8 * hl;
            f32x16 a2 = {};
#pragma unroll
            for (int s = 0; s < 16; ++s) a2 = mfma32(lds_ld<bf16x8>(L + (n * HP + 16 * s + 8 * hl) * 2), *(const bf16x8*)(B2 + 16 * s), a2);
            bf16_t* out = (bf16_t*)(ws + WS_KC) + ((size_t)(src * 16 + bg) * 256 + i0) * 64 + 32 * wave + n;
#pragma unroll
            for (int r = 0; r < 16; ++r) {
                const int row = 8 * (r >> 2) + 4 * hl + (r & 3);
                const float v = (i0 + row < 255) ? a2[r] : 0.f;
                out[(size_t)row * 64] = (bf16_t)(cvt_pk(v, 0.f) & 0xffffu);
            }
        }
        __syncthreads();
    }
    for (int seq = blockIdx.x; seq < 64; seq += gridDim.x) {
        const int b = seq >> 3, h = seq & 7;
        const bf16_t* fz = Z + (size_t)b * SEQ * ZLD + C_FC + h + (size_t)(8 * tid) * ZLD; const float bf = P.in[14][l * 8 + h];
        float v[8];
#pragma unroll
        for (int i = 0; i < 8; ++i) v[i] = bf2f(fz[(size_t)i * ZLD]);
#pragma unroll
        for (int i = 0; i < 8; ++i) v[i] = log_sigmoid(v[i] + bf);
#pragma unroll
        for (int i = 1; i < 8; ++i) v[i] += v[i - 1];
        const float tot = v[7]; float inc = tot;
#pragma unroll
        for (int o = 1; o < 64; o <<= 1) { const float u_ = __shfl_up(inc, o); if (lane >= o) inc += u_; }
        if (lane == 63) lds_st<float>(L + wave * 4, inc);
        __syncthreads();
        float base = 0.f;
        for (int w = 0; w < wave; ++w) base += lds_ld<float>(L + w * 4);
        const float excl = base + inc - tot;
        f32x4 o0, o1;
#pragma unroll
        for (int i = 0; i < 4; ++i) { o0[i] = -(excl + v[i]) * LOG2E; o1[i] = -(excl + v[4 + i]) * LOG2E; }
        f32x4* cp = (f32x4*)((float*)(ws + WS_CUM) + (size_t)seq * SEQ + 8 * tid);
        cp[0] = o0; cp[1] = o1;
        __syncthreads();
    }
}
constexpr float SC2 = 0.125f * LOG2E, RESC_THR = 12.f;
#ifndef STAG_FOX
#define STAG_FOX false
#endif
#ifndef STAG_NSA
#define STAG_NSA false
#endif
#ifndef STAG_SWA
#define STAG_SWA false
#endif
enum { MODE_FOX = 0, MODE_WIN = 1, MODE_SEL = 2, MODE_CMP1 = 3, MODE_CMP2 = 4 };
struct AttnIO { const bf16_t* K; const bf16_t* V; int pitch; int maxrow; const float* cg; };
typedef short v4i16_t __attribute__((ext_vector_type(4)));
__device__ __forceinline__ s16x4 tr16(lptr p) { return __builtin_bit_cast(s16x4, __builtin_amdgcn_ds_read_tr16_b64_v4i16((LAS v4i16_t*)p)); }

__device__ __forceinline__ float half_max(float x) { auto rr = __builtin_amdgcn_permlane32_swap(__float_as_uint(x), __float_as_uint(x), false, false); return fmaxf(__uint_as_float(rr[0]), __uint_as_float(rr[1])); }
__device__ __forceinline__ float half_sum(float x) { auto rr = __builtin_amdgcn_permlane32_swap(__float_as_uint(x), __float_as_uint(x), false, false); return __uint_as_float(rr[0]) + __uint_as_float(rr[1]); }
__device__ __forceinline__ float half_other(float x, int hl) { auto rr = __builtin_amdgcn_permlane32_swap(__float_as_uint(x), __float_as_uint(x), false, false); return hl ? __uint_as_float(rr[0]) : __uint_as_float(rr[1]); }
__device__ __forceinline__ float max3f(float a, float b, float c) { float r; asm("v_max3_f32 %0, %1, %2, %3" : "=v"(r) : "v"(a), "v"(b), "v"(c)); return r; }
constexpr int TABP = 392, TAB0 = 128;
template <int MODE>
__device__ __forceinline__ void attn_tile(lptr L, const int buf, const int vcur, const int kt, const bf16x8 (&qf)[4], const int t, const int wtmin, const int wtmax,
                                          const int tabofs, const int W, const unsigned mlo, const unsigned mhi, float& m, float& l, f32x16 (&o)[2],
                                          const float mfix, const float linv, const int score_ofs, float& carry, const float tab128, const int lane, f32x16& negm) {
    const int n = lane & 31, hl = lane >> 5, q4 = (lane & 15) >> 2, p4 = lane & 3, blk = (lane >> 4) & 1;
    bool active = true;
    if (MODE == MODE_FOX) active = (64 * kt <= wtmax);
    const bool selbit = (MODE == MODE_SEL) ? ((((kt < 32) ? (mlo >> kt) : (mhi >> (kt - 32))) & 1u) != 0u) : true;
    if (MODE == MODE_SEL) active = __any(selbit) != 0;
    if (active) {
        const lptr Kt = L + A_KT + buf * 9216, Vt = L + A_VT + vcur * 12288;
        f32x16 s0, s1;
#pragma unroll
        for (int s4 = 0; s4 < 4; ++s4) {
            const bf16x8 a0 = lds_ld<bf16x8>(Kt + n * KP + s4 * 32 + hl * 16);
            const bf16x8 a1 = lds_ld<bf16x8>(Kt + (32 + n) * KP + s4 * 32 + hl * 16);
            if (s4 == 0) { s0 = mfma32(a0, qf[0], negm); s1 = mfma32(a1, qf[0], negm); }
            else { s0 = mfma32(a0, qf[s4], s0); s1 = mfma32(a1, qf[s4], s1); }
        }
        const int kbase = 64 * kt + 4 * hl;
        const bool far = (MODE == MODE_WIN || MODE == MODE_SEL) ? (wtmin - (64 * kt + 63) >= 128) : false;
        const bool fmask = (MODE == MODE_FOX) ? (64 * kt + 63 > wtmin) : false;
        const bool clean = (MODE == MODE_WIN) ? (far && (wtmax - 64 * kt < W)) : false;
        const float mref = (MODE == MODE_CMP2) ? mfix : ((m == -INFINITY) ? 0.f : m);
        if (MODE == MODE_FOX) {
#pragma unroll
            for (int kb = 0; kb < 2; ++kb)
#pragma unroll
                for (int a = 0; a < 4; ++a) {
                    const f32x4 c4 = lds_ld<f32x4>(L + A_CB + buf * 256 + (32 * kb + 8 * a + 4 * hl) * 4);
#pragma unroll
                    for (int e = 0; e < 4; ++e) { const int r = 4 * a + e; if (kb) s1[r] = s1[r] * SC2 + c4[e]; else s0[r] = s0[r] * SC2 + c4[e]; }
                }
            if (__builtin_amdgcn_readfirstlane((int)fmask)) {
#pragma unroll
                for (int r = 0; r < 16; ++r) {
                    const int key = kbase + 8 * (r >> 2) + (r & 3);
                    if (key > t) s0[r] = -INFINITY;
                    if (key + 32 > t) s1[r] = -INFINITY;
                }
            }
        } else if (clean || (MODE == MODE_SEL && far)) {
            const float add = (MODE == MODE_SEL && !selbit) ? -INFINITY : tab128;
#pragma unroll
            for (int r = 0; r < 16; ++r) { s0[r] = s0[r] * SC2 + add; s1[r] = s1[r] * SC2 + add; }
        } else if (MODE == MODE_WIN || MODE == MODE_SEL) {
            const int dbase = t - kbase;
            const lptr tb = L + tabofs + (dbase + TAB0 - 63) * 4;
#pragma unroll
            for (int kb = 0; kb < 2; ++kb)
#pragma unroll
                for (int a = 0; a < 4; ++a)
#pragma unroll
                    for (int e = 0; e < 4; ++e) {
                        const int r = 4 * a + e, off = 32 * kb + 8 * a + e; const int d = dbase - off;
                        const float bsv = far ? tab128 : lds_ld<float>(tb + 4 * (63 - off));
                        const bool ok = (MODE == MODE_WIN) ? ((unsigned)d < (unsigned)W) : (selbit && d >= 0);
                        const float sv = kb ? s1[r] : s0[r];
                        const float x = ok ? sv * SC2 + bsv : -INFINITY;
                        if (kb) s1[r] = x; else s0[r] = x;
                    }
        } else if (wtmin - (16 * (64 * kt + 63) + 31) >= 128) {
#pragma unroll
            for (int r = 0; r < 16; ++r) { s0[r] = s0[r] * SC2 + tab128; s1[r] = s1[r] * SC2 + tab128; }
        } else {
#pragma unroll
            for (int kb = 0; kb < 2; ++kb)
#pragma unroll
                for (int a = 0; a < 4; ++a)
#pragma unroll
                    for (int e = 0; e < 4; ++e) {
                        const int r = 4 * a + e; const int key = kbase + 32 * kb + 8 * a + e; const int d = t - (16 * key + 31);
                        int di = d < 0 ? 0 : d; di = di > 128 ? 128 : di;
                        const float bsv = lds_ld<float>(L + tabofs + (di + TAB0) * 4);
                        const float sv = kb ? s1[r] : s0[r];
                        const float x = (d >= 0) ? sv * SC2 + bsv : -INFINITY;
                        if (kb) s1[r] = x; else s0[r] = x;
                    }
        }
        if (MODE != MODE_CMP2) {
            float mx = max3f(s0[0], s1[0], s0[1]);
#pragma unroll
            for (int r = 1; r < 15; r += 2) { mx = max3f(mx, s1[r], s0[r + 1]); mx = max3f(mx, s1[r + 1], (r + 2 < 16) ? s0[r + 2] : s1[r + 1]); }
            mx = fmaxf(mx, s1[15]);
            mx = half_max(mx);
            const bool minf = (m == -INFINITY);
            if (__any((mx > RESC_THR) || (minf && mx > -INFINITY))) {
                const float delta = minf ? ((mx == -INFINITY) ? 0.f : mx) : fmaxf(mx, 0.f);
                m = (minf && mx == -INFINITY) ? -INFINITY : mref + delta;
                { const float nm = (m == -INFINITY) ? 0.f : -m * (1.0f / SC2);
#pragma unroll
                  for (int r = 0; r < 16; ++r) negm[r] = nm; }
                const float alpha = minf ? 1.f : ex2(-delta);
                l *= alpha;
                if (MODE != MODE_CMP1) { o[0] = o[0] * alpha; o[1] = o[1] * alpha; }
#pragma unroll
                for (int r = 0; r < 16; ++r) { s0[r] -= delta; s1[r] -= delta; }
            }
            float ps = 0.f;
#pragma unroll
            for (int r = 0; r < 16; ++r) { s0[r] = ex2(s0[r]); s1[r] = ex2(s1[r]); ps += s0[r] + s1[r]; }
            l += ps;
        } else {
#pragma unroll
            for (int r = 0; r < 16; ++r) { s0[r] = ex2(s0[r]) * linv; s1[r] = ex2(s1[r]) * linv; }
            float quad[8], last[8], recv[8];
#pragma unroll
            for (int a = 0; a < 4; ++a) {
                quad[a] = (s0[4 * a] + s0[4 * a + 1]) + (s0[4 * a + 2] + s0[4 * a + 3]); last[a] = s0[4 * a + 3];
                quad[4 + a] = (s1[4 * a] + s1[4 * a + 1]) + (s1[4 * a + 2] + s1[4 * a + 3]); last[4 + a] = s1[4 * a + 3];
            }
#pragma unroll
            for (int i = 0; i < 8; ++i) recv[i] = half_other(last[i], hl);
#pragma unroll
            for (int i = 0; i < 8; ++i) {
                const float prev = (i > 0) ? recv[i > 0 ? i - 1 : 0] : carry;
                float v = quad[i] + (hl ? recv[i] : prev);
                v += __shfl_xor(v, 1); v += __shfl_xor(v, 2);
                if ((n & 3) == 0) lds_st<float>(L + score_ofs + (16 * kt + 2 * i + hl) * 4, v);
            }
            carry = recv[7];
        }
        if (MODE != MODE_CMP1) {
            bf16x8 pf[4];
#pragma unroll
            for (int ks = 0; ks < 4; ++ks) {
                const int hb = 8 * (ks & 1); u32x4 w;
                if (ks >> 1) { w.x = cvt_pk(s1[hb], s1[hb + 1]); w.y = cvt_pk(s1[hb + 2], s1[hb + 3]); w.z = cvt_pk(s1[hb + 4], s1[hb + 5]); w.w = cvt_pk(s1[hb + 6], s1[hb + 7]); }
                else { w.x = cvt_pk(s0[hb], s0[hb + 1]); w.y = cvt_pk(s0[hb + 2], s0[hb + 3]); w.z = cvt_pk(s0[hb + 4], s0[hb + 5]); w.w = cvt_pk(s0[hb + 6], s0[hb + 7]); }
                pf[ks] = __builtin_bit_cast(bf16x8, w);
            }
            const lptr vb_ = Vt + (4 * hl + q4) * VP + 32 * blk + 8 * p4;
#pragma unroll
            for (int c_ = 0; c_ < 2; ++c_)
#pragma unroll
                for (int ks_ = 0; ks_ < 4; ++ks_) {
                    const s16x4 lo_ = tr16(vb_ + (16 * ks_) * VP + 64 * c_), hi_ = tr16(vb_ + (16 * ks_ + 8) * VP + 64 * c_);
                    const bf16x8 vf_ = {lo_[0], lo_[1], lo_[2], lo_[3], hi_[0], hi_[1], hi_[2], hi_[3]};
                    o[c_] = mfma32(vf_, pf[ks_], o[c_]);
                }
        }
    }
}
template <int MODE, bool PRE>
__device__ __forceinline__ void attn_loop(lptr L, const AttnIO io, const unsigned long long umask, const bf16x8 (&qf)[4], const int t, const int wtmin, const int wtmax,
                                          const int tabofs, const int W, const unsigned mlo, const unsigned mhi, float& m, float& l, f32x16 (&o)[2],
                                          const float mfix, const float linv, const int score_ofs, const u32x4 pk = u32x4{}, const u32x4 pv = u32x4{}) {
    const int tid = otid(), lane = tid & 63;
    const int srow = tid >> 3, sch = tid & 7;
    if (umask == 0ull) return;
    int kt = __builtin_ctzll(umask); unsigned long long rem = umask & (umask - 1ull);
    u32x4 kA, vA, kB, vB; float cA = 0.f, cB = 0.f;
#define STAGE_LOAD(KT, KR, VR, CR) do { int gr_ = 64 * (KT) + srow; gr_ = gr_ > io.maxrow ? io.maxrow : gr_; const size_t off_ = (size_t)gr_ * io.pitch + sch * 8; \
        KR = *(const u32x4*)(io.K + off_); VR = *(const u32x4*)(io.V + off_); if (MODE == MODE_FOX) { if (tid < 64) CR = io.cg[64 * (KT) + tid]; } } while (0)
#define STAGE_STORE(B, VB, KR, VR, CR) do { lds_st<u32x4>(L + A_KT + (B) * 9216 + srow * KP + sch * 16, KR); lds_st<u32x4>(L + A_VT + (VB) * 12288 + srow * VP + sch * 16, VR); \
        if (MODE == MODE_FOX) { if (tid < 64) lds_st<float>(L + A_CB + (B) * 256 + tid * 4, CR); } } while (0)
#define NEXT_TILE(X) do { X = rem ? __builtin_ctzll(rem) : -1; rem &= rem - 1ull; } while (0)
    if (PRE) { kA = pk; vA = pv; } else { STAGE_LOAD(kt, kA, vA, cA); }
    STAGE_STORE(0, 0, kA, vA, cA);
    int nk, nnk; NEXT_TILE(nk);
    if (nk >= 0) STAGE_LOAD(nk, kA, vA, cA);
    __syncthreads();
    int buf = 0, vcur = 0, vnext = 1; float carry = 0.f;
    const float tab128 = (MODE == MODE_FOX) ? 0.f : lds_ld<float>(L + tabofs + (128 + TAB0) * 4);
    f32x16 negm;
    { const float nm0 = (MODE == MODE_CMP2) ? -mfix * (1.0f / SC2) : ((m == -INFINITY) ? 0.f : -m * (1.0f / SC2));
#pragma unroll
      for (int r = 0; r < 16; ++r) negm[r] = nm0; }
    for (;;) {
        NEXT_TILE(nnk);
        if (nnk >= 0) STAGE_LOAD(nnk, kB, vB, cB);
        attn_tile<MODE>(L, buf, vcur, kt, qf, t, wtmin, wtmax, tabofs, W, mlo, mhi, m, l, o, mfix, linv, score_ofs, carry, tab128, lane, negm);
        if (nk >= 0) STAGE_STORE(buf ^ 1, vnext, kA, vA, cA);
        __syncthreads();
        if (nk < 0) break;
        kt = nk; nk = nnk; buf ^= 1; vcur = vnext; vnext ^= 1;
        NEXT_TILE(nnk);
        if (nnk >= 0) STAGE_LOAD(nnk, kA, vA, cA);
        attn_tile<MODE>(L, buf, vcur, kt, qf, t, wtmin, wtmax, tabofs, W, mlo, mhi, m, l, o, mfix, linv, score_ofs, carry, tab128, lane, negm);
        if (nk >= 0) STAGE_STORE(buf ^ 1, vnext, kB, vB, cB);
        __syncthreads();
        if (nk < 0) break;
        kt = nk; nk = nnk; buf ^= 1; vcur = vnext; vnext ^= 1;
    }
#undef STAGE_LOAD
#undef STAGE_STORE
#undef NEXT_TILE
}
__device__ __forceinline__ void first_tile_load(const AttnIO io, const int kt, u32x4& pk, u32x4& pv) {
    const int tid = otid(), srow = tid >> 3, sch = tid & 7;
    int gr = 64 * kt + srow; gr = gr > io.maxrow ? io.maxrow : gr;
    const size_t off = (size_t)gr * io.pitch + sch * 8;
    pk = *(const u32x4*)(io.K + off); pv = *(const u32x4*)(io.V + off);
}
__device__ __forceinline__ unsigned long long tile_bits(int lo, int hi) {
    const unsigned long long up = (hi >= 63) ? ~0ull : ((1ull << (hi + 1)) - 1ull);
    return up & ~((1ull << lo) - 1ull);
}
__device__ __forceinline__ void store_o(bf16_t* orow, const f32x16 (&o)[2], float sc, int hl) {
#pragma unroll
    for (int c = 0; c < 2; ++c)
#pragma unroll
        for (int a = 0; a < 4; ++a) {
            u32x2 w; w.x = cvt_pk(o[c][4 * a] * sc, o[c][4 * a + 1] * sc); w.y = cvt_pk(o[c][4 * a + 2] * sc, o[c][4 * a + 3] * sc);
            *(u32x2*)(orow + 32 * c + 8 * a + 4 * hl) = w;
        }
}
__device__ __forceinline__ void stash_put(lptr st, int lane, const f32x16 (&o)[2], float sc) {
#pragma unroll
    for (int c = 0; c < 2; ++c)
#pragma unroll
        for (int a = 0; a < 4; ++a) {
            u32x2 w; w.x = cvt_pk(o[c][4 * a] * sc, o[c][4 * a + 1] * sc); w.y = cvt_pk(o[c][4 * a + 2] * sc, o[c][4 * a + 3] * sc);
            lds_st<u32x2>(st + ((c * 4 + a) * 64 + lane) * 8, w);
        }
}
__device__ __forceinline__ void stash_add(lptr st, int lane, f32x16 (&o)[2], float sc) {
#pragma unroll
    for (int c = 0; c < 2; ++c)
#pragma unroll
        for (int a = 0; a < 4; ++a) {
            const u32x2 w = lds_ld<u32x2>(st + ((c * 4 + a) * 64 + lane) * 8);
            o[c][4 * a] = o[c][4 * a] * sc + __uint_as_float(w.x << 16); o[c][4 * a + 1] = o[c][4 * a + 1] * sc + __uint_as_float(w.x & 0xffff0000u);
            o[c][4 * a + 2] = o[c][4 * a + 2] * sc + __uint_as_float(w.y << 16); o[c][4 * a + 3] = o[c][4 * a + 3] * sc + __uint_as_float(w.y & 0xffff0000u);
        }
}
__device__ __forceinline__ void store_o_rows(lptr st, int lane, const f32x16 (&o)[2], float sc, bf16_t* gbase, const int gq) {
    const int n = lane & 31, hl = lane >> 5;
#pragma unroll
    for (int c = 0; c < 2; ++c)
#pragma unroll
        for (int a = 0; a < 4; ++a) {
            u32x2 w; w.x = cvt_pk(o[c][4 * a] * sc, o[c][4 * a + 1] * sc); w.y = cvt_pk(o[c][4 * a + 2] * sc, o[c][4 * a + 3] * sc);
            lds_st<u32x2>(st + n * 128 + (((4 * c + a) ^ (n & 7)) * 16) + 8 * hl, w);
        }
#pragma unroll
    for (int i = 0; i < 4; ++i) {
        const int col = i * 8 + (lane >> 3), ch = lane & 7;
        const u32x4 v = lds_ld<u32x4>(st + col * 128 + ((ch ^ (col & 7)) * 16));
        bf16_t* g = gbase + (gq ? ((col >> 2) * 512 + (col & 3) * 64) : col * 512) + ch * 8;
        *(u32x4*)g = v;
    }
}
__device__ __forceinline__ void fox_unit(lptr L, const Params& P, int b, int h, int qb) {
    const int tid_ = otid(); const int lane = tid_ & 63, wave = tid_ >> 6, n = lane & 31, hl = lane >> 5;
    const bf16_t* Zb = (const bf16_t*)(P.ws + WS_BIG) + (size_t)b * SEQ * ZLD;
    const int wtmin = qb * 256 + 32 * wave, t = wtmin + n;
    bf16x8 qf[4];
    { const bf16_t* qrow = Zb + (size_t)t * ZLD + C_QC + h * 64 + 8 * hl;
#pragma unroll
      for (int s = 0; s < 4; ++s) qf[s] = *(const bf16x8*)(qrow + 16 * s); }
    const AttnIO io{Zb + C_KC + h * 64, Zb + C_VC + h * 64, ZLD, SEQ - 1, (const float*)(P.ws + WS_CUM) + (size_t)(b * 8 + h) * SEQ};
    float m = -INFINITY, l = 0.f; f32x16 o[2] = {};
    attn_loop<MODE_FOX, false>(L, io, tile_bits(0, 4 * qb + 3), qf, t, wtmin, wtmin + 31, 0, 0, 0u, 0u, m, l, o, 0.f, 0.f, 0);
    const float lt = half_sum(l);
    store_o_rows(L + A_STASH + wave * 4096, lane, o, lt > 0.f ? 1.f / lt : 0.f, (bf16_t*)(P.ws + WS_OC) + (size_t)(b * SEQ + wtmin) * 512 + h * 64, 0);
}
__device__ __forceinline__ void swa_unit(lptr L, const Params& P, int layer, int b, int g, int qi) {
    const int tid_ = otid(); const int lane = tid_ & 63, wave = tid_ >> 6, n = lane & 31, hl = lane >> 5;
    const bf16_t* Zb = (const bf16_t*)(P.ws + WS_BIG) + (size_t)b * SEQ * ZLD;
    const int wtmin = 64 * qi + 8 * wave, t = wtmin + (n >> 2), head = g * 4 + (n & 3);
    bf16x8 qf[4];
    { const bf16_t* qrow = Zb + (size_t)t * ZLD + C_QB + head * 64 + 8 * hl;
#pragma unroll
      for (int s = 0; s < 4; ++s) qf[s] = *(const bf16x8*)(qrow + 16 * s); }
    const AttnIO io{Zb + C_KB + g * 64, Zb + C_VB + g * 64, ZLD, SEQ - 1, nullptr};
    float m = -INFINITY, l = 0.f; f32x16 o[2] = {};
    attn_loop<MODE_WIN, false>(L, io, tile_bits(qi >= 2 ? qi - 2 : 0, qi), qf, t, wtmin, wtmin + 7, A_TAB + (8 + head) * TABP * 4, 128, 0u, 0u, m, l, o, 0.f, 0.f, 0);
    const float lt = half_sum(l);
    const float sink = P.in[13][layer * 8 + head] * LOG2E;
    const float mm = fmaxf(m, sink), f = ex2(m - mm), den = lt * f + ex2(sink - mm);
    store_o_rows(L + A_STASH + wave * 4096, lane, o, f / den, (bf16_t*)(P.ws + WS_OB) + (size_t)(b * SEQ + wtmin) * 512 + g * 256, 1);
}
__device__ __forceinline__ void nsa_unit(lptr L, const Params& P, int b, int g, int qi) {
    const int tid = otid(), lane = tid & 63, wave = tid >> 6, n = lane & 31, hl = lane >> 5;
    const bf16_t* Zb = (const bf16_t*)(P.ws + WS_BIG) + (size_t)b * SEQ * ZLD;
    const int wtmin = 64 * qi + 8 * wave, ql = n >> 2, t = wtmin + ql, head = g * 4 + (n & 3);
    const int tabofs = A_TAB + head * TABP * 4;
    bf16x8 qf[4];
    { const bf16_t* qrow = Zb + (size_t)t * ZLD + C_QA + head * 64 + 8 * hl;
#pragma unroll
      for (int s = 0; s < 4; ++s) qf[s] = *(const bf16x8*)(qrow + 16 * s); }
    float gc, gs, gwn;
    { const bf16_t* gp = Zb + (size_t)t * ZLD + C_GA + head * 3; gc = sigmoidf_(bf2f(gp[0])); gs = sigmoidf_(bf2f(gp[1])); gwn = sigmoidf_(bf2f(gp[2])); }
    const lptr stash = L + A_STASH + wave * 4096;
    const AttnIO ioC{(const bf16_t*)(P.ws + WS_KC) + (size_t)(0 * 16 + b * 2 + g) * 256 * 64, (const bf16_t*)(P.ws + WS_KC) + (size_t)(1 * 16 + b * 2 + g) * 256 * 64, 64, 255, nullptr};
    const AttnIO ioS{Zb + C_KSLC + g * 64, Zb + C_VSLC + g * 64, ZLD, SEQ - 1, nullptr};
    const AttnIO ioW{Zb + C_KWIN + g * 64, Zb + C_VWIN + g * 64, ZLD, SEQ - 1, nullptr};
    const int wlo = qi >= 8 ? qi - 8 : 0;
    u32x4 pkn, pvn;
    {
        const unsigned long long um = tile_bits(0, (4 * qi + 2) >> 6);
        float m = -INFINITY, l = 0.f; f32x16 o[2] = {};
        first_tile_load(ioC, 0, pkn, pvn);
        attn_loop<MODE_CMP1, false>(L, ioC, um, qf, t, wtmin, wtmin + 7, tabofs, 0, 0u, 0u, m, l, o, 0.f, 0.f, 0);
        const float lt = half_sum(l);
        const float linv = lt > 0.f ? 1.f / lt : 0.f, mfix = (m == -INFINITY) ? 0.f : m;
#pragma unroll
        for (int i = 0; i < 8; ++i) lds_st<float>(L + A_SCORE + wave * 2048 + (i * 64 + lane) * 4, 0.f);
        const u32x4 pk2 = pkn, pv2 = pvn;
        first_tile_load(ioS, 0, pkn, pvn);
        attn_loop<MODE_CMP2, true>(L, ioC, um, qf, t, wtmin, wtmin + 7, tabofs, 0, 0u, 0u, m, l, o, mfix, linv, A_SCORE + wave * 2048 + ql * 256, pk2, pv2);
        stash_put(stash, lane, o, gc);
    }
#pragma unroll 1
    for (int q = 0; q < 8; ++q) {
        const int tq = wtmin + q, cur = tq >> 6, J = lane;
        const bool elig = (J >= 1) && (J <= cur - 2);
        float v = lds_ld<float>(L + A_SCORE + wave * 2048 + (q * 64 + lane) * 4);
        v = elig ? v : -INFINITY;
        const int nfree = 8 - (cur == 0 ? 1 : (cur == 1 ? 2 : 3));
        unsigned long long picked = 0ull;
#pragma unroll 1
        for (int it = 0; it < nfree; ++it) {
            const float vv = ((picked >> J) & 1ull) ? -INFINITY : v;
            float mxv = vv;
#pragma unroll
            for (int o_ = 1; o_ < 32; o_ <<= 1) mxv = fmaxf(mxv, __shfl_xor(mxv, o_));
            mxv = half_max(mxv);
            const unsigned long long cand = __ballot(vv == mxv && vv > -INFINITY);
            if (cand == 0ull) break;
            picked |= 1ull << __builtin_ctzll(cand);
        }
        const bool sel = (((picked >> J) & 1ull) != 0ull) || (J == 0) || (J == cur) || (J == cur - 1);
        const unsigned long long bm = __ballot(sel);
        if (lane == 0) { lds_st<unsigned>(L + A_SELM + (wave * 8 + q) * 8, (unsigned)bm); lds_st<unsigned>(L + A_SELM + (wave * 8 + q) * 8 + 4, (unsigned)(bm >> 32)); }
    }
    __syncthreads();
    unsigned ulo = lds_ld<unsigned>(L + A_SELM + lane * 8), uhi = lds_ld<unsigned>(L + A_SELM + lane * 8 + 4);
#pragma unroll
    for (int o_ = 1; o_ < 64; o_ <<= 1) { ulo |= (unsigned)__shfl_xor((int)ulo, o_); uhi |= (unsigned)__shfl_xor((int)uhi, o_); }
    ulo = __builtin_amdgcn_readfirstlane(ulo); uhi = __builtin_amdgcn_readfirstlane(uhi);
    const unsigned mlo = lds_ld<unsigned>(L + A_SELM + (wave * 8 + ql) * 8), mhi = lds_ld<unsigned>(L + A_SELM + (wave * 8 + ql) * 8 + 4);
    {
        float m = -INFINITY, l = 0.f; f32x16 o[2] = {};
        const u32x4 pk3 = pkn, pv3 = pvn;
        first_tile_load(ioW, wlo, pkn, pvn);
        attn_loop<MODE_SEL, true>(L, ioS, ((unsigned long long)uhi << 32) | ulo, qf, t, wtmin, wtmin + 7, tabofs, 0, mlo, mhi, m, l, o, 0.f, 0.f, 0, pk3, pv3);
        const float lt = half_sum(l); const float sc = (lt > 0.f ? 1.f / lt : 0.f) * gs;
        stash_add(stash, lane, o, sc); stash_put(stash, lane, o, 1.f);
    }
    {
        float m = -INFINITY, l = 0.f; f32x16 o[2] = {};
        attn_loop<MODE_WIN, true>(L, ioW, tile_bits(wlo, qi), qf, t, wtmin, wtmin + 7, tabofs, 512, 0u, 0u, m, l, o, 0.f, 0.f, 0, pkn, pvn);
        const float lt = half_sum(l); const float sc = (lt > 0.f ? 1.f / lt : 0.f) * gwn;
        stash_add(stash, lane, o, sc);
        store_o_rows(stash, lane, o, 1.f, (bf16_t*)(P.ws + WS_OA) + (size_t)(b * SEQ + wtmin) * 512 + g * 256, 1);
    }
}
__device__ __forceinline__ void attn_phase(lptr L, const Params& P, int layer) {
    const int tid = otid(), G = gridDim.x;
    const int blk = (G % 8 == 0) ? (int)(blockIdx.x % 8) * (G / 8) + (int)(blockIdx.x / 8) : (int)blockIdx.x;
    for (int i = tid; i < 16 * TABP; i += NT) {
        const int h = i / TABP, d = i - h * TABP - TAB0;
        float v = 0.f;
        if (d >= 0) {
            int bk = d;
            if (d >= 16) { bk = (d >= 128) ? 31 : 16 + (int)(logf((float)d * (1.f / 16.f)) / logf(8.f) * 16.f); bk = bk > 31 ? 31 : bk; }
            v = P.in[1][bk * 16 + h] * LOG2E;
        }
        lds_st<float>(L + A_TAB + i * 4, v);
    }
    __syncthreads();
#pragma unroll 1
    for (int p = blk; p < 512; p += G) {
#pragma unroll 1
        for (int j = 0; j < 2; ++j) {
#ifdef DBG_NO_FOX
            continue;
#endif
            const int bh = p >> 3, s = p & 7; fox_unit(L, P, bh >> 3, bh & 7, j ? 15 - s : s);
#ifdef PROBE_FOX2
            fox_unit(L, P, bh >> 3, bh & 7, j ? 15 - s : s);
#endif
        }
    }
#pragma unroll 1
    for (int p = blk; p < 512; p += G) {
#pragma unroll 1
        for (int j = 0; j < 2; ++j) {
#ifdef DBG_NO_NSA
            continue;
#endif
            const int bg = p >> 5, s = p & 31;
#ifdef PROBE_NSA2
            for (int rep_ = 0; rep_ < 2; ++rep_)
#endif
            nsa_unit(L, P, bg >> 1, bg & 1, j ? 63 - s : s); }
    }
#pragma unroll 1
    for (int u = blk; u < 1024; u += G) {
#ifdef DBG_NO_SWA
        continue;
#endif
        const int bg = u >> 6; swa_unit(L, P, layer, bg >> 1, bg & 1, u & 63); }
}
__global__ void __launch_bounds__(NT, 2) mk_fwd(Params P) {
    __shared__ __attribute__((aligned(16))) unsigned char lds_raw[LDS_BYTES];
    const lptr L = (lptr)lds_raw;
    cg::grid_group grid = cg::this_grid();
    unsigned char* ws = P.ws;
    bf16_t* XN = (bf16_t*)(ws + WS_XN); bf16_t* BIG = (bf16_t*)(ws + WS_BIG);
    const int G = gridDim.x;
    if (otid() < 4) lds_st<unsigned>(L + A_XB + otid() * 4, 0u);
    __syncthreads();
    XcdBarrier xbar = xcd_barrier_post((unsigned*)(ws + WS_BAR), (volatile LAS unsigned*)(L + A_XB));
    prep_x(P);
#pragma unroll 1
    for (int l = 0; l < DEPTH; ++l) {
#pragma unroll 1
        for (int si = 0; si < 14; ++si) {
            const int st = (si <= 7) ? si : (si == 8 ? 13 : si - 1);
            const int bx = obid();
#ifdef DBG_SKIP_LO
            if (st >= DBG_SKIP_LO && st <= DBG_SKIP_HI) continue;
#endif
            if (st == 0) {
                prep_weights(L, P, l);
#ifdef PROBE_PREP2
                __syncthreads(); prep_weights(L, P, l);
#endif
            } else if (st == 1 || st == 10) {
                pg8::Gemm g{XN, (const bf16_t*)(ws + (st == 1 ? W_1A : W_1B)), M, 2 * DFF, DM}; pg8::StaticOrder S; S.init(M, 2 * DFF, G, bx);
                EpiSwiGLU E{BIG};
                pg8::gemm_phase<EpiSwiGLU, pg8::StaticOrder, true, true>((PG8_LAS unsigned char*)L, g, S, E);
#ifdef PROBE_UP2
                pg8::gemm_phase<EpiSwiGLU, pg8::StaticOrder, true, true>((PG8_LAS unsigned char*)L, g, S, E);
#endif
            } else if (st == 2 || st == 11 || st == 8) {
                const bf16_t* A = (st == 8) ? (const bf16_t*)(ws + WS_MRG) : BIG;
                const bf16_t* Bt = (const bf16_t*)(ws + (st == 8 ? W_O : (st == 2 ? W_2A : W_2B)));
                pg8::Gemm g{A, Bt, M, DM, st == 8 ? DM : DFF}; pg8::StaticOrder S; S.init(M, DM, G, bx);
                const float* eg = (st == 2) ? (l ? P.in[25] + (l - 1) * DM : nullptr) : (st == 8 ? P.in[2] + l * DM : P.in[21] + l * DM);
                const float* eb = (st == 2) ? (l ? P.in[26] + (l - 1) * DM : nullptr) : (st == 8 ? P.in[3] + l * DM : P.in[22] + l * DM);
                EpiResid E{P.out, (const float*)(ws + WS_STATS), eg, eb, ALPHA, st == 8 ? 1.0f : 0.5f};
                pg8::gemm_phase<EpiResid, pg8::StaticOrder, true, true>((PG8_LAS unsigned char*)L, g, S, E);
#ifdef PROBE_RESID2
                { EpiResid E2{P.out, (const float*)(ws + WS_STATS), nullptr, nullptr, 1.0f, 0.0f};
                  pg8::gemm_phase<EpiResid, pg8::StaticOrder, true, true>((PG8_LAS unsigned char*)L, g, S, E2); }
#endif
            } else if (st == 3 || st == 9 || st == 12) {
                const float* lg = st == 3 ? P.in[2] : (st == 9 ? P.in[21] : P.in[25]); const float* lb = st == 3 ? P.in[3] : (st == 9 ? P.in[22] : P.in[26]);
                ln_pass(P, lg + l * DM, lb + l * DM, l == DEPTH - 1 && st == 12);
            } else if (st == 4) {
                pg8::Gemm g{XN, (const bf16_t*)(ws + W_Z), M, 3840, DM}; pg8::StaticOrder S; S.init(M, 3840, G, bx);
                EpiZ E{BIG};
                pg8::gemm_phase<EpiZ, pg8::StaticOrder, true, true>((PG8_LAS unsigned char*)L, g, S, E);
#ifdef PROBE_Z2
                pg8::gemm_phase<EpiZ, pg8::StaticOrder, true, true>((PG8_LAS unsigned char*)L, g, S, E);
#endif
            } else if (st == 5) {
                compress_phase(L, P, l);
#ifdef PROBE_CMP2
                __syncthreads(); compress_phase(L, P, l);
#endif
            } else if (st == 6) {
                attn_phase(L, P, l);
#ifdef PROBE_ATTN2
                __syncthreads(); attn_phase(L, P, l);
#endif
            } else if (st == 7) {
                pg8::Gemm g{XN, (const bf16_t*)(ws + W_G), M, 3 * DM, DM}; pg8::StaticOrder S; S.init(M, 3 * DM, G, bx);
                EpiGate E{(bf16_t*)(ws + WS_GATE), P.in[19] + (size_t)l * 3 * DM};
                pg8::gemm_phase<EpiGate, pg8::StaticOrder, true, true>((PG8_LAS unsigned char*)L, g, S, E);
#ifdef PROBE_GATE2
                pg8::gemm_phase<EpiGate, pg8::StaticOrder, true, true>((PG8_LAS unsigned char*)L, g, S, E);
#endif
            } else if (st == 13) {
                pg8::Gemm g{(const bf16_t*)(ws + WS_OA), (const bf16_t*)(ws + W_BR), 3 * M, 3 * DM, 512}; MergeOrder S; S.base.init(M, DM, G, bx);
                EpiMerge E{(const bf16_t*)(ws + WS_GATE), (bf16_t*)(ws + WS_MRG)};
                pg8::gemm_phase<EpiMerge, MergeOrder, true, true>((PG8_LAS unsigned char*)L, g, S, E);
            }
            if (l == 0 && st == 0) grid.sync();
            xcd_barrier(xbar);
#ifdef PROBE_XB2
            xcd_barrier(xbar); xcd_barrier(xbar);
#endif
        }
    }
}
}

extern "C" void kernel_launch(void* const* d_in, const int* in_sizes, int n_in, void* d_out, int out_size, void* d_ws, size_t ws_size, hipStream_t stream) {
    static int grid = 0;
    if (grid == 0) {
        if (n_in != 27 || out_size != mk::M * mk::DM || ws_size < mk::WS_TOTAL) { fprintf(stderr, "kernel_launch: unexpected shapes (n_in %d, out %d, ws %zu)\n", n_in, out_size, ws_size); grid = -1; return; }
        int dev = 0, cus = 0, per_cu = 0;
        hipGetDevice(&dev); hipDeviceGetAttribute(&cus, hipDeviceAttributeMultiprocessorCount, dev);
        hipOccupancyMaxActiveBlocksPerMultiprocessor(&per_cu, (const void*)mk::mk_fwd, mk::NT, 0);
        if (per_cu < 1) { fprintf(stderr, "kernel_launch: occupancy query says %d blocks/CU\n", per_cu); per_cu = 1; }
        grid = cus * 1;
    }
    if (grid < 0) return;
    if (hipMemsetAsync((char*)d_ws + mk::WS_BAR, 0, 16384, stream) != hipSuccess) { fprintf(stderr, "memset failed\n"); return; }
    mk::Params p{};
    for (int i = 0; i < 27; ++i) p.in[i] = (const float*)d_in[i];
    p.out = (float*)d_out; p.ws = (unsigned char*)d_ws;
    void* args[] = {&p};
    hipError_t e = hipLaunchCooperativeKernel((const void*)mk::mk_fwd, dim3(grid), dim3(mk::NT), args, 0, stream);
    if (e != hipSuccess) fprintf(stderr, "cooperative launch failed: %s (grid %d)\n", hipGetErrorString(e), grid);
}
```

```cpp
#include <hip/hip_runtime.h>
#include <hip/hip_cooperative_groups.h>
#include <cstdio>
#include <cstdint>
namespace cg = cooperative_groups;
__device__ __forceinline__ int otid() { int t = threadIdx.x; asm volatile("" : "+v"(t)); return t; }
__device__ __forceinline__ int obid() { int t = blockIdx.x; asm volatile("" : "+s"(t)); return t; }
#ifndef PROBE_ST7N
#define PROBE_ST7N 1
#endif
namespace pg8 {
#define PG8_LAS __attribute__((address_space(3)))
typedef unsigned short bf16_t;
typedef short bf16x8 __attribute__((ext_vector_type(8)));
typedef float f32x4 __attribute__((ext_vector_type(4)));
typedef unsigned u32x4 __attribute__((ext_vector_type(4)));
constexpr int BM = 256, BK = 64, HALF = 128, HTB = HALF * BK * 2  , STAGE_BYTES = 8 * HTB, NXCD = 8, WGM = 8;

__host__ __device__ __forceinline__ int lds_byte(int r, int c) { const int st = (r >> 4) * 2 + (c >> 5), rr = r & 15, cc = c & 31, ob = rr * 64 + cc * 2; return st * 1024 + (ob ^ (((ob >> 9) & 1) << 5)); }
__host__ __device__ __forceinline__ void stage_rc(int b, int& R, int& C) { const int st = b / 1024, sb = b % 1024, swz = sb ^ (((sb >> 9) & 1) << 5); R = (st >> 1) * 16 + swz / 64; C = (st & 1) * 32 + (swz % 64) / 2; }
__host__ __device__ __forceinline__ int perm32(int rho) { const int n = rho >> 4, i = rho & 15; return 8 * (i >> 2) + 4 * n + (i & 3); }

struct Unit { int pm, pn; };
struct Gemm { const bf16_t* A; const bf16_t* Bt; int M, N, K; };

struct StaticOrder {
    int nM, nN, nwg, G, c;
    __host__ __device__ void init(int M, int N, int G_, int c_) { nM = M / BM; nN = N / BM; nwg = nM * nN; G = G_; c = c_; }
    __host__ __device__ bool next(int i, Unit& u) const {
        const long L = (long)i * G + c; if (L >= nwg) return false;
        int wgid = (int)L; { const int q = nwg / NXCD, r = nwg % NXCD, xcd = wgid % NXCD, off = wgid / NXCD; wgid = (xcd < r ? xcd * (q + 1) : r * (q + 1) + (xcd - r) * q) + off; }
        const int nig = WGM * nN, gid = wgid / nig, fm = gid * WGM, gsz = (nM - fm) < WGM ? (nM - fm) : WGM;
        u.pm = fm + ((wgid % nig) % gsz); u.pn = (wgid % nig) / gsz; return true;
    }
    __device__ __forceinline__ void a_ready(const Unit&) const {}
    __device__ __forceinline__ void done(const Unit&) const {}
};

__device__ __forceinline__ unsigned cvt_pk_bf16(float lo, float hi) { unsigned r; asm volatile("v_cvt_pk_bf16_f32 %0, %1, %2" : "=v"(r) : "v"(lo), "v"(hi)); return r; }
typedef float f32x2 __attribute__((ext_vector_type(2)));
__device__ __forceinline__ f32x2 gelu_pk(f32x2 v) {
    const f32x2 av = __builtin_elementwise_abs(v), d = av * 0.2316418882f + 1.0f;
    f32x2 t; t.x = __builtin_amdgcn_rcpf(d.x); t.y = __builtin_amdgcn_rcpf(d.y);
    f32x2 q = t * 0.5307027145f + (-0.7265760135f); q = q * t + 0.7107068705f; q = q * t + (-0.142248368f); q = q * t + 0.127414796f; q = q * t;
    const f32x2 s = (v * v) * (-0.72134752044f);
    f32x2 e; e.x = __builtin_amdgcn_exp2f(s.x); e.y = __builtin_amdgcn_exp2f(s.y);
    const f32x2 m = v * (q * e), r = v - m;
    f32x2 o; o.x = v.x < 0.f ? m.x : r.x; o.y = v.y < 0.f ? m.y : r.y; return o;
}

template <int ACT  > struct EpiBf16 {
    static constexpr bool PERM = true, AFTER_DRAIN = false, CARRY = false; static_assert(ACT == 0 || ACT == 1, "EpiBf16: ACT is 0 (none) or 1 (gelu_pk)");
    bf16_t* O; int ldc; const float* bias; int split_cols; size_t split_stride; float scale0;
    __device__ __forceinline__ void operator()(const f32x4 (&acc)[2][2][4][2], const Unit& u, int wr, int wc, int fr, int fq) const {
        const int row0 = u.pm * BM + wr * 64 + fr; int colt = u.pn * BM; bf16_t* base = O;
        float sc = 1.f; if (split_cols) { const int t = colt / split_cols; base += (size_t)t * split_stride; colt -= t * split_cols; if (t == 0) sc = scale0; }
        const int col0 = colt + wc * 32 + 8 * fq, bcol0 = u.pn * BM + wc * 32 + 8 * fq;
        f32x4 bv[2][2];
#pragma unroll
        for (int bj = 0; bj < 2; ++bj)
#pragma unroll
            for (int n = 0; n < 2; ++n) bv[bj][n] = bias ? *(const f32x4*)(bias + bcol0 + bj * HALF + 4 * n) : (f32x4){0.f, 0.f, 0.f, 0.f};
#pragma unroll
        for (int ai = 0; ai < 2; ++ai)
#pragma unroll
            for (int m = 0; m < 4; ++m) { bf16_t* rowp = base + (size_t)(row0 + ai * HALF + m * 16) * ldc + col0;
#pragma unroll
                for (int bj = 0; bj < 2; ++bj) { f32x4 v0 = acc[ai][bj][m][0] + bv[bj][0], v1 = acc[ai][bj][m][1] + bv[bj][1];
                    if (ACT == 1) { f32x2 a = gelu_pk((f32x2){v0[0], v0[1]}), b = gelu_pk((f32x2){v0[2], v0[3]}), c = gelu_pk((f32x2){v1[0], v1[1]}), d = gelu_pk((f32x2){v1[2], v1[3]});
                        v0 = (f32x4){a.x, a.y, b.x, b.y}; v1 = (f32x4){c.x, c.y, d.x, d.y}; }
                    v0 = v0 * sc; v1 = v1 * sc; u32x4 w; w.x = cvt_pk_bf16(v0[0], v0[1]); w.y = cvt_pk_bf16(v0[2], v0[3]); w.z = cvt_pk_bf16(v1[0], v1[1]); w.w = cvt_pk_bf16(v1[2], v1[3]);
                    *(u32x4*)(rowp + bj * HALF) = w; } }
    }
};
template <class Epi, class Sched, bool ALIGN_EPI = false, bool SP2 = false>
__device__ __forceinline__ void gemm_phase(PG8_LAS unsigned char* lds, const Gemm g, const Sched& S, const Epi& E) {
    const int tid = otid(), wid = __builtin_amdgcn_readfirstlane(tid >> 6), lane = tid & 63, wr = wid >> 2, wc = wid & 3, fr = lane & 15, fq = lane >> 4;
    const int K = g.K, nt = K / BK;
    unsigned voffA[2], voffB[2];
#pragma unroll
    for (int i = 0; i < 2; ++i) { int R, C; stage_rc(tid * 16 + i * 8192, R, C); const int Rb = Epi::PERM ? ((R & ~31) + perm32(R & 31)) : R;
        voffA[i] = (unsigned)(R * K + C) * 2u; voffB[i] = (unsigned)(Rb * K + C) * 2u; }
    const size_t kstep = (size_t)(BK * 2);
    const size_t hstep = (size_t)HALF * K * 2;
    const size_t tstep = 2 * hstep;
    const unsigned ldsw = (unsigned)wid * 1024u;
    const int aoff = lds_byte(wr * 64 + fr, fq * 8), boff = lds_byte(wc * 32 + fr, fq * 8);
#define PG8_SA(b, h) (((b) * 2 + (h)) * HTB)
#define PG8_SB(b, h) ((4 + (b) * 2 + (h)) * HTB)
#define PG8_STAGE(bufoff, gbase, voff) do { _Pragma("unroll") for (int _i = 0; _i < 2; ++_i) \
        __builtin_amdgcn_global_load_lds((const unsigned*)((const char*)(gbase) + (voff)[_i]), (PG8_LAS unsigned*)(lds + (bufoff) + ldsw + _i * 8192), 16, 0, 0); } while (0)
#define PG8_LDA(dst, b, h) do { _Pragma("unroll") for (int m = 0; m < 4; ++m) _Pragma("unroll") for (int k = 0; k < 2; ++k) dst[m][k] = *(const PG8_LAS bf16x8*)(lds + PG8_SA(b, h) + aoff + m * 2048 + k * 1024); } while (0)
#define PG8_LDB(dst, b, h) do { _Pragma("unroll") for (int n = 0; n < 2; ++n) _Pragma("unroll") for (int k = 0; k < 2; ++k) dst[n][k] = *(const PG8_LAS bf16x8*)(lds + PG8_SB(b, h) + boff + n * 2048 + k * 1024); } while (0)
#define PG8_MMA(ai, bj, At, Bt) do { __builtin_amdgcn_s_setprio(1); _Pragma("unroll") for (int m = 0; m < 4; ++m) _Pragma("unroll") for (int n = 0; n < 2; ++n) _Pragma("unroll") for (int k = 0; k < 2; ++k) \
        acc[ai][bj][m][n] = __builtin_amdgcn_mfma_f32_16x16x32_bf16(Bt[n][k], At[m][k], acc[ai][bj][m][n], 0, 0, 0); __builtin_amdgcn_s_setprio(0); } while (0)
#define PG8_WAIT_V(n) asm volatile("s_waitcnt vmcnt(" #n ")" ::: "memory")
#define PG8_WAIT_L(n) asm volatile("s_waitcnt lgkmcnt(" #n ")" ::: "memory")
#define PG8_BAR __builtin_amdgcn_s_barrier()
#define PG8_SCHED __builtin_amdgcn_sched_barrier(0)
    Unit cur, nxt; int ui = 0;
    if (!S.next(0, cur)) return;
    f32x4 acc[2][2][4][2];
#pragma unroll
    for (int a = 0; a < 2; ++a)
#pragma unroll
        for (int b = 0; b < 2; ++b)
#pragma unroll
            for (int m = 0; m < 4; ++m)
#pragma unroll
                for (int n = 0; n < 2; ++n) acc[a][b][m][n] = (f32x4){0.f, 0.f, 0.f, 0.f};
    bf16x8 At[4][2], B0[2][2], B1[2][2];
    const char* cA = (const char*)g.A + (size_t)cur.pm * tstep; const char* cB = (const char*)g.Bt + (size_t)cur.pn * tstep;
    S.a_ready(cur);
    if constexpr (SP2) {
        PG8_STAGE(PG8_SB(0, 0), cB, voffB); PG8_STAGE(PG8_SB(0, 1), cB + hstep, voffB); PG8_STAGE(PG8_SA(0, 0), cA, voffA); PG8_STAGE(PG8_SA(0, 1), cA + hstep, voffA);
        if (wr == 1) PG8_BAR;
        PG8_WAIT_V(2); PG8_BAR;
        PG8_STAGE(PG8_SB(1, 0), cB + kstep, voffB); PG8_STAGE(PG8_SA(1, 0), cA + kstep, voffA); PG8_STAGE(PG8_SB(1, 1), cB + hstep + kstep, voffB);
        PG8_WAIT_V(6); PG8_BAR;
    } else {
        PG8_STAGE(PG8_SB(0, 0), cB, voffB); PG8_STAGE(PG8_SA(0, 0), cA, voffA); PG8_STAGE(PG8_SB(0, 1), cB + hstep, voffB); PG8_STAGE(PG8_SA(0, 1), cA + hstep, voffA);
        if (wr == 1) PG8_BAR;
        PG8_WAIT_V(4); PG8_BAR;
        PG8_STAGE(PG8_SB(1, 0), cB + kstep, voffB); PG8_STAGE(PG8_SA(1, 0), cA + kstep, voffA); PG8_STAGE(PG8_SB(1, 1), cB + hstep + kstep, voffB);
        PG8_WAIT_V(6); PG8_BAR;
    }
    for (;;) {
        const bool has_next = S.next(ui + 1, nxt);
        const char* nA = has_next ? (const char*)g.A + (size_t)nxt.pm * tstep : cA; const char* nB = has_next ? (const char*)g.Bt + (size_t)nxt.pn * tstep : cB;
        for (int t = 0; t < nt; t += 2) {
            const bool last = (t == nt - 2);
            const char* a1 = cA + (size_t)(t + 1) * kstep;
            const char* a2 = last ? nA : cA + (size_t)(t + 2) * kstep; const char* b2 = last ? nB : cB + (size_t)(t + 2) * kstep;
            const char* a3 = a2 + kstep; const char* b3 = b2 + kstep;
            if (last && has_next) S.a_ready(nxt);
            if constexpr (SP2) {
            PG8_LDB(B0, 0, 0); PG8_LDB(B1, 0, 1); PG8_SCHED; PG8_LDA(At, 0, 0); PG8_STAGE(PG8_SA(1, 1), a1 + hstep, voffA);
            PG8_WAIT_V(8); PG8_WAIT_L(0); PG8_BAR; PG8_MMA(0, 0, At, B0); PG8_MMA(0, 1, At, B1); PG8_BAR; PG8_SCHED;
            PG8_LDA(At, 0, 1); PG8_STAGE(PG8_SB(0, 0), b2, voffB); PG8_STAGE(PG8_SB(0, 1), b2 + hstep, voffB); PG8_STAGE(PG8_SA(0, 0), a2, voffA);
            PG8_WAIT_V(8); PG8_WAIT_L(0); PG8_BAR; PG8_MMA(1, 0, At, B0); PG8_MMA(1, 1, At, B1); PG8_BAR; PG8_SCHED;
            PG8_LDB(B0, 1, 0); PG8_LDB(B1, 1, 1); PG8_SCHED; PG8_LDA(At, 1, 0); PG8_STAGE(PG8_SA(0, 1), a2 + hstep, voffA);
            PG8_WAIT_V(8); PG8_WAIT_L(0); PG8_BAR; PG8_MMA(0, 0, At, B0); PG8_MMA(0, 1, At, B1); PG8_BAR; PG8_SCHED;
            PG8_LDA(At, 1, 1); PG8_STAGE(PG8_SB(1, 0), b3, voffB); PG8_STAGE(PG8_SB(1, 1), b3 + hstep, voffB); PG8_STAGE(PG8_SA(1, 0), a3, voffA);
            PG8_WAIT_V(8); PG8_WAIT_L(0); PG8_BAR; PG8_MMA(1, 0, At, B0); PG8_MMA(1, 1, At, B1); PG8_BAR; PG8_SCHED;
            } else {
            PG8_LDB(B0, 0, 0); PG8_SCHED; PG8_LDA(At, 0, 0); PG8_STAGE(PG8_SA(1, 1), a1 + hstep, voffA);
            PG8_WAIT_L(8); PG8_BAR; PG8_WAIT_L(0); PG8_MMA(0, 0, At, B0); PG8_BAR; PG8_SCHED;
            PG8_LDB(B1, 0, 1); PG8_STAGE(PG8_SB(0, 0), b2, voffB);
            PG8_BAR; PG8_WAIT_L(0); PG8_MMA(0, 1, At, B1); PG8_BAR;
            PG8_LDA(At, 0, 1); PG8_STAGE(PG8_SA(0, 0), a2, voffA);
            PG8_BAR; PG8_WAIT_L(0); PG8_MMA(1, 0, At, B0); PG8_BAR; PG8_SCHED;
            PG8_STAGE(PG8_SB(0, 1), b2 + hstep, voffB);
            PG8_WAIT_V(6); PG8_BAR; PG8_MMA(1, 1, At, B1); PG8_BAR;
            PG8_LDB(B0, 1, 0); PG8_SCHED; PG8_LDA(At, 1, 0); PG8_STAGE(PG8_SA(0, 1), a2 + hstep, voffA);
            PG8_WAIT_L(8); PG8_BAR; PG8_WAIT_L(0); PG8_MMA(0, 0, At, B0); PG8_BAR; PG8_SCHED;
            PG8_LDB(B1, 1, 1); PG8_STAGE(PG8_SB(1, 0), b3, voffB);
            PG8_BAR; PG8_WAIT_L(0); PG8_MMA(0, 1, At, B1); PG8_BAR;
            PG8_LDA(At, 1, 1); PG8_STAGE(PG8_SA(1, 0), a3, voffA);
            PG8_BAR; PG8_WAIT_L(0); PG8_MMA(1, 0, At, B0); PG8_BAR; PG8_SCHED;
            PG8_STAGE(PG8_SB(1, 1), b3 + hstep, voffB);
            PG8_WAIT_V(6); PG8_BAR; PG8_MMA(1, 1, At, B1); PG8_BAR;
            }
        }
        if constexpr (ALIGN_EPI) { if (wr == 0) PG8_BAR; }
        bool keep_acc = false;
        if constexpr (!Epi::AFTER_DRAIN) { if constexpr (Epi::CARRY) keep_acc = E.carry(acc, cur, wr, wc, fr, fq); else E(acc, cur, wr, wc, fr, fq); S.done(cur); }
        if (!has_next) break;
        if (!keep_acc)
#pragma unroll
        for (int a = 0; a < 2; ++a)
#pragma unroll
            for (int b = 0; b < 2; ++b)
#pragma unroll
                for (int m = 0; m < 4; ++m)
#pragma unroll
                    for (int n = 0; n < 2; ++n) acc[a][b][m][n] = (f32x4){0.f, 0.f, 0.f, 0.f};
        cur = nxt; cA = nA; cB = nB; ++ui;
        if constexpr (ALIGN_EPI) { if (wr == 1) PG8_BAR; }
    }
    PG8_WAIT_V(0);
    if constexpr (!ALIGN_EPI) { if (wr == 0) PG8_BAR; }
    PG8_BAR;
    if constexpr (Epi::AFTER_DRAIN) { E.fused(acc, cur, wr, wc, fr, fq, lds, wid, lane); S.done(cur); }
#undef PG8_SA
#undef PG8_SB
#undef PG8_STAGE
#undef PG8_LDA
#undef PG8_LDB
#undef PG8_MMA
#undef PG8_WAIT_V
#undef PG8_WAIT_L
#undef PG8_BAR
#undef PG8_SCHED
}
}
namespace mk {
using pg8::bf16_t; using pg8::bf16x8; using pg8::f32x4; using pg8::u32x4; using pg8::Unit;
#define LAS __attribute__((address_space(3)))
typedef LAS unsigned char* lptr;
typedef float f32x16 __attribute__((ext_vector_type(16)));
typedef short s16x4 __attribute__((ext_vector_type(4)));
typedef unsigned u32x2 __attribute__((ext_vector_type(2)));
template <class T> __device__ __forceinline__ T lds_ld(lptr p) { return *(const LAS T*)p; }
template <class T> __device__ __forceinline__ void lds_st(lptr p, T v) { *(LAS T*)p = v; }

constexpr int BATCH = 8, SEQ = 4096, DM = 1024, DEPTH = 4, M = BATCH * SEQ, DFF = 2816, ZLD = 3616, NT = 512;
constexpr int C_QA = 0, C_KCMP = 512, C_VCMP = 640, C_KSLC = 768, C_VSLC = 896, C_KWIN = 1024, C_VWIN = 1152, C_GA = 1280, C_QB = 1304, C_KB = 1816, C_VB = 1944,
              C_QC = 2072, C_KC = 2584, C_VC = 3096, C_FC = 3608;
constexpr float ALPHA = 1.6817928305074290f, LOG2E = 1.4426950408889634f, LN_EPS = 1e-5f;
constexpr size_t MiB = 1u << 20;
constexpr size_t W_1A = 0, W_2A = W_1A + 11534336, W_Z = W_2A + 5767168, W_G = W_Z + 7864320, W_BR = W_G + 6291456, W_O = W_BR + 3145728, W_1B = W_O + 2097152,
                 W_2B = W_1B + 11534336, W_C1 = W_2B + 5767168, W_C2 = W_C1 + 2097152, W_PEB = W_C2 + 65536, W_END = W_PEB + 65536;
static_assert(W_END <= 54 * MiB, "weights region");
constexpr size_t WS_XN = 54 * MiB, WS_BIG = 118 * MiB, WS_GATE = WS_BIG, WS_MRG = WS_XN, WS_OA = 344 * MiB, WS_OB = 376 * MiB, WS_OC = 408 * MiB,
                 WS_KC = 440 * MiB, WS_CUM = 441 * MiB, WS_BAR = 442 * MiB, WS_STATS = 443 * MiB, WS_TOTAL = 444 * MiB;
static_assert((size_t)M * ZLD * 2 <= 226 * MiB, "Z fits");
constexpr int LDS_BYTES = 144 * 1024;
constexpr int A_KT = 0, A_VT = 18432, A_CB = 43008, A_SCORE = 43520, A_SELM = 59904, A_STASH = 60416, A_TAB = 93184, A_XB = 140000, KP = 144, VP = 192;

struct Params { const float* in[27]; float* out; unsigned char* ws; };

typedef float f32x2_t __attribute__((ext_vector_type(2))); typedef __bf16 bf16x2_t __attribute__((ext_vector_type(2)));
__device__ __forceinline__ unsigned cvt_pk(float lo, float hi) { f32x2_t v = {lo, hi}; bf16x2_t b = __builtin_convertvector(v, bf16x2_t); return __builtin_bit_cast(unsigned, b); }
__device__ __forceinline__ float bf2f(bf16_t v) { return __uint_as_float((unsigned)v << 16); }
__device__ __forceinline__ float ex2(float x) { return __builtin_amdgcn_exp2f(x); }
__device__ __forceinline__ float sigmoidf_(float x) { return __builtin_amdgcn_rcpf(1.0f + ex2(-x * LOG2E)); }
__device__ __forceinline__ f32x16 mfma32(bf16x8 a, bf16x8 b, f32x16 c) { return __builtin_amdgcn_mfma_f32_32x32x16_bf16(a, b, c, 0, 0, 0); }
__device__ __forceinline__ float wave_sum(float v) {
#pragma unroll
    for (int o = 1; o < 64; o <<= 1) v += __shfl_xor(v, o);
    return v;
}

struct EpiSwiGLU {
    static constexpr bool PERM = true, AFTER_DRAIN = false, CARRY = false; bf16_t* H;
    __device__ __forceinline__ void operator()(const f32x4 (&acc)[2][2][4][2], const Unit& u, int wr, int wc, int fr, int fq) const {
        const int row0 = u.pm * 256 + wr * 64 + fr, col0 = u.pn * 128 + wc * 32 + 8 * fq;
#pragma unroll
        for (int ai = 0; ai < 2; ++ai)
#pragma unroll
            for (int m = 0; m < 4; ++m) {
                bf16_t* rowp = H + (size_t)(row0 + ai * 128 + m * 16) * DFF + col0;
                float h[8];
#pragma unroll
                for (int n = 0; n < 2; ++n)
#pragma unroll
                    for (int e = 0; e < 4; ++e) { const float g = acc[ai][0][m][n][e], up = acc[ai][1][m][n][e]; h[n * 4 + e] = g * sigmoidf_(g) * up; }
                u32x4 w; w.x = cvt_pk(h[0], h[1]); w.y = cvt_pk(h[2], h[3]); w.z = cvt_pk(h[4], h[5]); w.w = cvt_pk(h[6], h[7]);
                *(u32x4*)rowp = w;
            }
    }
};
struct EpiResid {
    static constexpr bool PERM = true, AFTER_DRAIN = false, CARRY = false; float* X; const float* stats; const float* lng; const float* lnb; float ca, cb;
    __device__ __forceinline__ void operator()(const f32x4 (&acc)[2][2][4][2], const Unit& u, int wr, int wc, int fr, int fq) const {
        const int row0 = u.pm * 256 + wr * 64 + fr, col0 = u.pn * 256 + wc * 32 + 8 * fq;
#pragma unroll
        for (int bj = 0; bj < 2; ++bj) {
            const int c = col0 + bj * 128;
            f32x4 g0 = {1.f, 1.f, 1.f, 1.f}, g1 = g0, b0 = {0.f, 0.f, 0.f, 0.f}, b1 = b0;
            if (lng) { g0 = *(const f32x4*)(lng + c); g1 = *(const f32x4*)(lng + c + 4); b0 = *(const f32x4*)(lnb + c); b1 = *(const f32x4*)(lnb + c + 4); }
            g0 = g0 * ca; g1 = g1 * ca; b0 = b0 * ca; b1 = b1 * ca;
#pragma unroll
            for (int ai = 0; ai < 2; ++ai)
#pragma unroll
                for (int m = 0; m < 4; ++m) {
                    const int row = row0 + ai * 128 + m * 16;
                    float mean = 0.f, rstd = 1.f;
                    if (lng) { const float2 st = *(const float2*)(stats + 2 * (size_t)row); mean = st.x; rstd = st.y; }
                    float* p = X + (size_t)row * DM + c;
                    f32x4 x0 = *(const f32x4*)p, x1 = *(const f32x4*)(p + 4);
                    x0 = (x0 - mean) * rstd * g0 + b0 + acc[ai][bj][m][0] * cb; x1 = (x1 - mean) * rstd * g1 + b1 + acc[ai][bj][m][1] * cb;
                    *(f32x4*)p = x0; *(f32x4*)(p + 4) = x1;
                    if (m & 1) asm volatile("" ::: "memory");
                }
        }
    }
};
struct EpiZ {
    static constexpr bool PERM = true, AFTER_DRAIN = false, CARRY = false; bf16_t* Z;
    __device__ __forceinline__ void operator()(const f32x4 (&acc)[2][2][4][2], const Unit& u, int wr, int wc, int fr, int fq) const {
        const int row0 = u.pm * 256 + wr * 64 + fr, col0 = u.pn * 256 + wc * 32 + 8 * fq;
#pragma unroll
        for (int ai = 0; ai < 2; ++ai)
#pragma unroll
            for (int m = 0; m < 4; ++m)
#pragma unroll
                for (int bj = 0; bj < 2; ++bj) {
                    const int c = col0 + bj * 128;
                    if (c < ZLD) {
                        const f32x4 v0 = acc[ai][bj][m][0], v1 = acc[ai][bj][m][1];
                        u32x4 w; w.x = cvt_pk(v0[0], v0[1]); w.y = cvt_pk(v0[2], v0[3]); w.z = cvt_pk(v1[0], v1[1]); w.w = cvt_pk(v1[2], v1[3]);
                        *(u32x4*)(Z + (size_t)(row0 + ai * 128 + m * 16) * ZLD + c) = w;
                    }
                }
    }
};
struct EpiGate {
    static constexpr bool PERM = true, AFTER_DRAIN = false, CARRY = false; bf16_t* G; const float* bias;
    __device__ __forceinline__ void operator()(const f32x4 (&acc)[2][2][4][2], const Unit& u, int wr, int wc, int fr, int fq) const {
        const int row0 = u.pm * 256 + wr * 64 + fr, col0 = u.pn * 256 + wc * 32 + 8 * fq;
#pragma unroll
        for (int bj = 0; bj < 2; ++bj) {
            const int c = col0 + bj * 128;
            const f32x4 b0 = *(const f32x4*)(bias + c), b1 = *(const f32x4*)(bias + c + 4);
#pragma unroll
            for (int ai = 0; ai < 2; ++ai)
#pragma unroll
                for (int m = 0; m < 4; ++m) {
                    const f32x4 v0 = acc[ai][bj][m][0] + b0, v1 = acc[ai][bj][m][1] + b1;
                    u32x4 w; w.x = cvt_pk(sigmoidf_(v0[0]), sigmoidf_(v0[1])); w.y = cvt_pk(sigmoidf_(v0[2]), sigmoidf_(v0[3]));
                    w.z = cvt_pk(sigmoidf_(v1[0]), sigmoidf_(v1[1])); w.w = cvt_pk(sigmoidf_(v1[2]), sigmoidf_(v1[3]));
                    *(u32x4*)(G + (size_t)(row0 + ai * 128 + m * 16) * (3 * DM) + c) = w;
                }
        }
    }
};
struct EpiMerge {
    static constexpr bool PERM = true, AFTER_DRAIN = false, CARRY = true; const bf16_t* G; bf16_t* Mg;
    __device__ __forceinline__ bool carry(f32x4 (&acc)[2][2][4][2], const Unit& u, int wr, int wc, int fr, int fq) const {
        const int br = u.pn >> 2, pm = u.pm - 128 * br, pn = u.pn & 3;
        const int row0 = pm * 256 + wr * 64 + fr, col0 = pn * 256 + wc * 32 + 8 * fq;
#pragma unroll
        for (int ai = 0; ai < 2; ++ai)
#pragma unroll
            for (int m = 0; m < 4; ++m)
#pragma unroll
                for (int bj = 0; bj < 2; ++bj) {
                    const size_t row = (size_t)(row0 + ai * 128 + m * 16); const int c = col0 + bj * 128;
                    const u32x4 gn = *(const u32x4*)(G + row * (3 * DM) + br * DM + c);
                    float f[8];
#pragma unroll
                    for (int j = 0; j < 4; ++j) { f[2 * j] = __uint_as_float(gn[j] << 16); f[2 * j + 1] = __uint_as_float(gn[j] & 0xffff0000u); }
                    if (br < 2) {
                        const u32x4 gd = *(const u32x4*)(G + row * (3 * DM) + (br + 1) * DM + c);
#pragma unroll
                        for (int j = 0; j < 4; ++j) {
                            f[2 * j] *= __builtin_amdgcn_rcpf(fmaxf(__uint_as_float(gd[j] << 16), 1e-30f));
                            f[2 * j + 1] *= __builtin_amdgcn_rcpf(fmaxf(__uint_as_float(gd[j] & 0xffff0000u), 1e-30f));
                        }
#pragma unroll
                        for (int i = 0; i < 8; ++i) acc[ai][bj][m][i >> 2][i & 3] *= f[i];
                    } else {
                        float v[8];
#pragma unroll
                        for (int i = 0; i < 8; ++i) v[i] = acc[ai][bj][m][i >> 2][i & 3] * f[i];
                        u32x4 w; w.x = cvt_pk(v[0], v[1]); w.y = cvt_pk(v[2], v[3]); w.z = cvt_pk(v[4], v[5]); w.w = cvt_pk(v[6], v[7]);
                        *(u32x4*)(Mg + row * DM + c) = w;
                    }
                }
        return br < 2;
    }
};
struct MergeOrder {
    pg8::StaticOrder base;
    __device__ __forceinline__ bool next(int i, Unit& u) const { Unit t; if (!base.next(i / 3, t)) return false; const int br = i % 3; u.pm = t.pm + 128 * br; u.pn = t.pn + 4 * br; return true; }
    __device__ __forceinline__ void a_ready(const Unit&) const {}
    __device__ __forceinline__ void done(const Unit&) const {}
};
#define XB_TMO      128
#define XB_XCNT(j)  (256  + 64 * (j))
#define XB_XSUB(j)  (1280 + 64 * (j))
#define XB_XGEN(j)  (2304 + 64 * (j))
#define XB_TOP      3328
#define XB_TOPGEN   3392
#define XCD_BAR_WORDS 3456
#define XB_SPIN_CAP (1u << 18)

__device__ __forceinline__ unsigned xb_ld(unsigned* p)              { return __hip_atomic_load(p, __ATOMIC_RELAXED, __HIP_MEMORY_SCOPE_AGENT); }
__device__ __forceinline__ unsigned xb_add(unsigned* p, unsigned v) { return __hip_atomic_fetch_add(p, v, __ATOMIC_RELAXED, __HIP_MEMORY_SCOPE_AGENT); }
__device__ __forceinline__ unsigned xb_xcc_id() { return (unsigned)__builtin_amdgcn_s_getreg((3 << 11) | 20) & 0xFu; }
#define XB_SPIN(cond, bar) do { unsigned _sp = 0; while (cond) { __builtin_amdgcn_s_sleep(1); \
    if ((++_sp & 255u) == 0u) { if (xb_ld(&(bar)[XB_TMO])) break; if (_sp > XB_SPIN_CAP) { atomicAdd(&(bar)[XB_TMO], 1u); break; } } } } while (0)

struct XcdBarrier {
    unsigned* bar; unsigned x;
    volatile LAS unsigned* st;
};

__device__ __forceinline__ XcdBarrier xcd_barrier_post(unsigned* bar, volatile LAS unsigned* st) {
    XcdBarrier b; b.bar = bar; b.x = xb_xcc_id(); b.st = st;
    if (threadIdx.x == 0) (void)xb_add(&bar[XB_XCNT(b.x)], 1u);
    return b;
}
__device__ __forceinline__ void xcd_barrier_complete(unsigned* bar, unsigned x, unsigned& nloc, unsigned& nx) {
    const unsigned G = gridDim.x * gridDim.y * gridDim.z;
    unsigned sum, cnt, mine, sp = 0u;
    for (;;) {
        sum = 0u; cnt = 0u; mine = 0u;
#pragma unroll
        for (unsigned j = 0; j < 16; ++j) { const unsigned c = xb_ld(&bar[XB_XCNT(j)]); sum += c; cnt += (c > 0u) ? 1u : 0u; mine = (j == x) ? c : mine; }
        if (sum == G) break;
        __builtin_amdgcn_s_sleep(1);
        if ((++sp & 255u) == 0u) { if (xb_ld(&bar[XB_TMO])) break; if (sp > XB_SPIN_CAP) { atomicAdd(&bar[XB_TMO], 1u); break; } }
    }
    nloc = mine > 0u ? mine : 1u; nx = cnt > 0u ? cnt : 1u;
}

__device__ __forceinline__ void xcd_barrier(const XcdBarrier& b) {
    asm volatile("s_waitcnt vmcnt(0)" ::: "memory");
    __syncthreads();
    if (threadIdx.x == 0) {
        unsigned* bar = b.bar;
        __builtin_amdgcn_s_waitcnt(0);
        unsigned nloc = b.st[0], nx = b.st[1];
        if (nloc == 0u) { xcd_barrier_complete(bar, b.x, nloc, nx); b.st[0] = nloc; b.st[1] = nx; }
        const unsigned old = xb_add(&bar[XB_XSUB(b.x)], 1u);
        const unsigned gen = old / nloc;
        if (old + 1u == (gen + 1u) * nloc) {
            __builtin_amdgcn_fence(__ATOMIC_RELEASE, "agent");
            asm volatile("s_waitcnt vmcnt(0)" ::: "memory");
            const unsigned og = xb_add(&bar[XB_TOP], 1u);
            const unsigned tg = og / nx;
            if (og + 1u == (tg + 1u) * nx) xb_add(&bar[XB_TOPGEN], 1u);
            else XB_SPIN(xb_ld(&bar[XB_TOPGEN]) == tg, bar);
            __builtin_amdgcn_fence(__ATOMIC_ACQUIRE, "agent");
            xb_add(&bar[XB_XGEN(b.x)], 1u);
            asm volatile("s_waitcnt vmcnt(0)" ::: "memory");
        } else {
            XB_SPIN(xb_ld(&bar[XB_XGEN(b.x)]) == gen, bar);
            __builtin_amdgcn_fence(__ATOMIC_ACQUIRE, "agent");
            asm volatile("s_waitcnt vmcnt(0)" ::: "memory");
        }
    }
    __syncthreads();
}

__device__ __forceinline__ void tr_item(const float* W, int ldw, int K, int k0, int n0, bf16_t* WT, int drow0, lptr scr, int lane) {
    f32x4 tv[8];
#pragma unroll
    for (int i = 0; i < 8; ++i) tv[i] = *(const f32x4*)(W + (size_t)(k0 + 8 * i + (lane >> 3)) * ldw + n0 + 4 * (lane & 7));
#pragma unroll
    for (int i = 0; i < 8; ++i) {
        const lptr d_ = scr + ((8 * i + (lane >> 3)) * 33 + 4 * (lane & 7)) * 4;
        lds_st<float>(d_, tv[i][0]); lds_st<float>(d_ + 4, tv[i][1]); lds_st<float>(d_ + 8, tv[i][2]); lds_st<float>(d_ + 12, tv[i][3]);
    }
    const int c = lane & 7;
#pragma unroll
    for (int j = 0; j < 4; ++j) {
        const int n = (lane >> 3) + 8 * j; const lptr s = scr + ((8 * c) * 33 + n) * 4;
        u32x4 o; o.x = cvt_pk(lds_ld<float>(s), lds_ld<float>(s + 33 * 4)); o.y = cvt_pk(lds_ld<float>(s + 2 * 33 * 4), lds_ld<float>(s + 3 * 33 * 4));
        o.z = cvt_pk(lds_ld<float>(s + 4 * 33 * 4), lds_ld<float>(s + 5 * 33 * 4)); o.w = cvt_pk(lds_ld<float>(s + 6 * 33 * 4), lds_ld<float>(s + 7 * 33 * 4));
        *(u32x4*)(WT + (size_t)(drow0 + n) * K + k0 + 8 * c) = o;
    }
}
__device__ __forceinline__ void prep_weights(lptr L, const Params& P, int l) {
    const int tid = otid(), lane = tid & 63, wave = tid >> 6;
    const int gw = blockIdx.x * 8 + wave, NGW = gridDim.x * 8;
    const lptr scr = L + wave * 8704;
    unsigned char* ws = P.ws;
#pragma unroll 1
    for (int mi = 0; mi < 14; ++mi) {
        const float* W; int K, N, mode = 0; bf16_t* WT;
        switch (mi) {
            case 0: W = P.in[4] + (size_t)l * DM * 2 * DFF; K = DM; N = 2 * DFF; WT = (bf16_t*)(ws + W_1A); mode = 1; break;
            case 1: W = P.in[5] + (size_t)l * DFF * DM; K = DFF; N = DM; WT = (bf16_t*)(ws + W_2A); break;
            case 2: W = P.in[6] + (size_t)l * DM * ZLD; K = DM; N = ZLD; WT = (bf16_t*)(ws + W_Z); break;
            case 3: W = P.in[18] + (size_t)l * DM * 3 * DM; K = DM; N = 3 * DM; WT = (bf16_t*)(ws + W_G); break;
            case 4: W = P.in[15] + (size_t)l * 512 * DM; K = 512; N = DM; WT = (bf16_t*)(ws + W_BR); break;
            case 5: W = P.in[16] + (size_t)l * 512 * DM; K = 512; N = DM; WT = (bf16_t*)(ws + W_BR) + 1 * DM * 512; break;
            case 6: W = P.in[17] + (size_t)l * 512 * DM; K = 512; N = DM; WT = (bf16_t*)(ws + W_BR) + 2 * DM * 512; break;
            case 7: W = P.in[20] + (size_t)l * DM * DM; K = DM; N = DM; WT = (bf16_t*)(ws + W_O); break;
            case 8: W = P.in[23] + (size_t)l * DM * 2 * DFF; K = DM; N = 2 * DFF; WT = (bf16_t*)(ws + W_1B); mode = 1; break;
            case 9: W = P.in[24] + (size_t)l * DFF * DM; K = DFF; N = DM; WT = (bf16_t*)(ws + W_2B); break;
            case 10: W = P.in[9] + (size_t)l * 2048 * 256; K = 2048; N = 256; WT = (bf16_t*)(ws + W_C1); break;
            case 11: W = P.in[11] + (size_t)l * 2048 * 256; K = 2048; N = 256; WT = (bf16_t*)(ws + W_C1) + 256 * 2048; break;
            case 12: W = P.in[10] + (size_t)l * 256 * 64; K = 256; N = 64; WT = (bf16_t*)(ws + W_C2); break;
            default: W = P.in[12] + (size_t)l * 256 * 64; K = 256; N = 64; WT = (bf16_t*)(ws + W_C2) + 64 * 256; break;
        }
        const int nblk = N / 32, nitems = (K / 64) * nblk;
        for (int it = gw; it < nitems; it += NGW) {
            const int kb = it / nblk, nb = it - kb * nblk, n0 = 32 * nb;
            int drow0 = n0;
            if (mode == 1) { const int up = n0 >= DFF, nn = up ? n0 - DFF : n0; drow0 = 256 * (nn >> 7) + (up ? 128 : 0) + (nn & 127); }
            tr_item(W, N, K, 64 * kb, n0, WT, drow0, scr, lane);
        }
    }
    if (blockIdx.x < 32) {
        const int src = blockIdx.x >> 4, part = (blockIdx.x & 15) * 2 + (tid >> 8), n = tid & 255;
        const float* pe = (src ? P.in[8] : P.in[7]) + (size_t)l * 2048; const float* w1 = (src ? P.in[11] : P.in[9]) + (size_t)l * 2048 * 256;
        float s = 0.f;
        for (int k = 64 * part; k < 64 * part + 64; ++k) s += pe[k] * w1[(size_t)k * 256 + n];
        ((float*)(ws + W_PEB))[(src * 32 + part) * 256 + n] = s;
    }
}
__device__ __forceinline__ void prep_x(const Params& P) {
    const size_t n4 = (size_t)M * DM / 4; const f32x4* xi = (const f32x4*)P.in[0]; f32x4* xo = (f32x4*)P.out; u32x2* xn = (u32x2*)(P.ws + WS_XN);
    for (size_t i = (size_t)obid() * NT + otid(); i < n4; i += (size_t)gridDim.x * NT) {
        const f32x4 v = xi[i]; xo[i] = v; u32x2 w; w.x = cvt_pk(v[0], v[1]); w.y = cvt_pk(v[2], v[3]); xn[i] = w;
    }
}
__device__ __forceinline__ void ln_pass(const Params& P, const float* g, const float* b, const bool write_x) {
    const int tid_ = otid(); const int lane = tid_ & 63, wave = tid_ >> 6;
    const int gw = blockIdx.x * 8 + wave, NGW = gridDim.x * 8;
    f32x4 gv[4], bv[4];
#pragma unroll
    for (int j = 0; j < 4; ++j) { gv[j] = ((const f32x4*)g)[lane + 64 * j]; bv[j] = ((const f32x4*)b)[lane + 64 * j]; }
    float* stats = (float*)(P.ws + WS_STATS);
    for (int r0 = gw * 4; r0 < M; r0 += NGW * 4) {
        f32x4 v[4][4];
#pragma unroll
        for (int q = 0; q < 4; ++q) {
            const f32x4* xr = (const f32x4*)(P.out + (size_t)(r0 + q) * DM) + lane;
#pragma unroll
            for (int j = 0; j < 4; ++j) v[q][j] = xr[64 * j];
        }
#pragma unroll
        for (int q = 0; q < 4; ++q) {
            float s = 0.f;
#pragma unroll
            for (int j = 0; j < 4; ++j) s += (v[q][j][0] + v[q][j][1]) + (v[q][j][2] + v[q][j][3]);
            const float mean = wave_sum(s) * (1.f / DM); float s2 = 0.f;
#pragma unroll
            for (int j = 0; j < 4; ++j) { v[q][j] = v[q][j] - mean; s2 += (v[q][j][0] * v[q][j][0] + v[q][j][1] * v[q][j][1]) + (v[q][j][2] * v[q][j][2] + v[q][j][3] * v[q][j][3]); }
            const float rstd = 1.f / sqrtf(wave_sum(s2) * (1.f / DM) + LN_EPS);
            if (lane == 0) { float2 st; st.x = mean; st.y = rstd; *(float2*)(stats + 2 * (size_t)(r0 + q)) = st; }
            f32x4* xw = (f32x4*)(P.out + (size_t)(r0 + q) * DM) + lane;
            u32x2* o8 = (u32x2*)((bf16_t*)(P.ws + WS_XN) + (size_t)(r0 + q) * DM) + lane;
#pragma unroll
            for (int j = 0; j < 4; ++j) {
                const f32x4 y = v[q][j] * rstd * gv[j] + bv[j];
                if (write_x) xw[64 * j] = y;
                u32x2 w; w.x = cvt_pk(y[0], y[1]); w.y = cvt_pk(y[2], y[3]); o8[64 * j] = w;
            }
        }
    }
}
__device__ __forceinline__ float gelu_tanh(float x) {
    const float u = 0.7978845608028654f * (x + 0.044715f * x * x * x);
    const float t = ex2(2.f * LOG2E * u);
    return 0.5f * x * (2.f - 2.f * __builtin_amdgcn_rcpf(t + 1.f));
}
__device__ __forceinline__ float log_sigmoid(float x) { return x >= 0.f ? -log1pf(__expf(-x)) : x - log1pf(__expf(x)); }
__device__ __forceinline__ void compress_phase(lptr L, const Params& P, int l) {
    const int tid = otid(), lane = tid & 63, wave = tid >> 6, n = lane & 31, hl = lane >> 5;
    unsigned char* ws = P.ws; const bf16_t* Z = (const bf16_t*)(ws + WS_BIG);
    constexpr int HP = 264;
    for (int u = blockIdx.x; u < 256; u += gridDim.x) {
        const int src = u >> 7, bg = (u >> 3) & 15, rt = u & 7, b = bg >> 1, g = bg & 1, i0 = 32 * rt;
        const int coff = (src ? C_VCMP : C_KCMP) + g * 64;
        const bf16_t* Zb = Z + (size_t)b * SEQ * ZLD + coff + 8 * hl;
        const bf16_t* B1 = (const bf16_t*)(ws + W_C1) + (size_t)src * 256 * 2048 + (size_t)(32 * wave + n) * 2048 + 8 * hl;
        f32x16 acc = {};
        const int tok0 = 16 * (i0 + n);
#pragma unroll 2
        for (int p = 0; p < 32; ++p) {
            int tok = tok0 + p; tok = tok > SEQ - 1 ? SEQ - 1 : tok;
            const bf16_t* ar = Zb + (size_t)tok * ZLD; const bf16_t* br = B1 + p * 64;
#pragma unroll
            for (int s = 0; s < 4; ++s) acc = mfma32(*(const bf16x8*)(ar + 16 * s), *(const bf16x8*)(br + 16 * s), acc);
        }
        float peb = 0.f;
        { const float* pp = (const float*)(ws + W_PEB) + src * 32 * 256 + 32 * wave + n;
#pragma unroll 8
          for (int q = 0; q < 32; ++q) peb += pp[q * 256]; }
#pragma unroll
        for (int r = 0; r < 16; ++r) {
            const int row = 8 * (r >> 2) + 4 * hl + (r & 3);
            const float hv = gelu_tanh(acc[r] + peb);
            lds_st<bf16_t>(L + (row * HP + 32 * wave + n) * 2, (bf16_t)(cvt_pk(hv, 0.f) & 0xffffu));
        }
        __syncthreads();
        if (wave < 2) {
            const bf16_t* B2 = (const bf16_t*)(ws + W_C2) + (size_t)src * 64 * 256 + (size_t)(32 * wave + n) * 256 + 8 * hl;
            f32x16 a2 = {};
#pragma unroll
            for (int s = 0; s < 16; ++s) a2 = mfma32(lds_ld<bf16x8>(L + (n * HP + 16 * s + 8 * hl) * 2), *(const bf16x8*)(B2 + 16 * s), a2);
            bf16_t* out = (bf16_t*)(ws + WS_KC) + ((size_t)(src * 16 + bg) * 256 + i0) * 64 + 32 * wave + n;
#pragma unroll
            for (int r = 0; r < 16; ++r) {
                const int row = 8 * (r >> 2) + 4 * hl + (r & 3);
                const float v = (i0 + row < 255) ? a2[r] : 0.f;
                out[(size_t)row * 64] = (bf16_t)(cvt_pk(v, 0.f) & 0xffffu);
            }
        }
        __syncthreads();
    }
    for (int seq = blockIdx.x; seq < 64; seq += gridDim.x) {
        const int b = seq >> 3, h = seq & 7;
        const bf16_t* fz = Z + (size_t)b * SEQ * ZLD + C_FC + h + (size_t)(8 * tid) * ZLD; const float bf = P.in[14][l * 8 + h];
        float v[8];
#pragma unroll
        for (int i = 0; i < 8; ++i) v[i] = bf2f(fz[(size_t)i * ZLD]);
#pragma unroll
        for (int i = 0; i < 8; ++i) v[i] = log_sigmoid(v[i] + bf);
#pragma unroll
        for (int i = 1; i < 8; ++i) v[i] += v[i - 1];
        const float tot = v[7]; float inc = tot;
#pragma unroll
        for (int o = 1; o < 64; o <<= 1) { const float u_ = __shfl_up(inc, o); if (lane >= o) inc += u_; }
        if (lane == 63) lds_st<float>(L + wave * 4, inc);
        __syncthreads();
        float base = 0.f;
        for (int w = 0; w < wave; ++w) base += lds_ld<float>(L + w * 4);
        const float excl = base + inc - tot;
        f32x4 o0, o1;
#pragma unroll
        for (int i = 0; i < 4; ++i) { o0[i] = -(excl + v[i]) * LOG2E; o1[i] = -(excl + v[4 + i]) * LOG2E; }
        f32x4* cp = (f32x4*)((float*)(ws + WS_CUM) + (size_t)seq * SEQ + 8 * tid);
        cp[0] = o0; cp[1] = o1;
        __syncthreads();
    }
}
constexpr float SC2 = 0.125f * LOG2E, RESC_THR = 12.f;
#ifndef STAG_FOX
#define STAG_FOX false
#endif
#ifndef STAG_NSA
#define STAG_NSA false
#endif
#ifndef STAG_SWA
#define STAG_SWA false
#endif
enum { MODE_FOX = 0, MODE_WIN = 1, MODE_SEL = 2, MODE_CMP1 = 3, MODE_CMP2 = 4 };
struct AttnIO { const bf16_t* K; const bf16_t* V; int pitch; int maxrow; const float* cg; };
typedef short v4i16_t __attribute__((ext_vector_type(4)));
__device__ __forceinline__ s16x4 tr16(lptr p) { return __builtin_bit_cast(s16x4, __builtin_amdgcn_ds_read_tr16_b64_v4i16((LAS v4i16_t*)p)); }

__device__ __forceinline__ float half_max(float x) { auto rr = __builtin_amdgcn_permlane32_swap(__float_as_uint(x), __float_as_uint(x), false, false); return fmaxf(__uint_as_float(rr[0]), __uint_as_float(rr[1])); }
__device__ __forceinline__ float half_sum(float x) { auto rr = __builtin_amdgcn_permlane32_swap(__float_as_uint(x), __float_as_uint(x), false, false); return __uint_as_float(rr[0]) + __uint_as_float(rr[1]); }
__device__ __forceinline__ float half_other(float x, int hl) { auto rr = __builtin_amdgcn_permlane32_swap(__float_as_uint(x), __float_as_uint(x), false, false); return hl ? __uint_as_float(rr[0]) : __uint_as_float(rr[1]); }
__device__ __forceinline__ float max3f(float a, float b, float c) { float r; asm("v_max3_f32 %0, %1, %2, %3" : "=v"(r) : "v"(a), "v"(b), "v"(c)); return r; }
constexpr int TABP = 392, TAB0 = 128;
template <int MODE>
__device__ __forceinline__ void attn_tile(lptr L, const int buf, const int vcur, const int kt, const bf16x8 (&qf)[4], const int t, const int wtmin, const int wtmax,
                                          const int tabofs, const int W, const unsigned mlo, const unsigned mhi, float& m, float& l, f32x16 (&o)[2],
                                          const float mfix, const float linv, const int score_ofs, float& carry, const float tab128, const int lane, f32x16& negm) {
    const int n = lane & 31, hl = lane >> 5, q4 = (lane & 15) >> 2, p4 = lane & 3, blk = (lane >> 4) & 1;
    bool active = true;
    if (MODE == MODE_FOX) active = (64 * kt <= wtmax);
    const bool selbit = (MODE == MODE_SEL) ? ((((kt < 32) ? (mlo >> kt) : (mhi >> (kt - 32))) & 1u) != 0u) : true;
    if (MODE == MODE_SEL) active = __any(selbit) != 0;
    if (active) {
        const lptr Kt = L + A_KT + buf * 9216, Vt = L + A_VT + vcur * 12288;
        f32x16 s0, s1;
#pragma unroll
        for (int s4 = 0; s4 < 4; ++s4) {
            const bf16x8 a0 = lds_ld<bf16x8>(Kt + n * KP + s4 * 32 + hl * 16);
            const bf16x8 a1 = lds_ld<bf16x8>(Kt + (32 + n) * KP + s4 * 32 + hl * 16);
            if (s4 == 0) { s0 = mfma32(a0, qf[0], negm); s1 = mfma32(a1, qf[0], negm); }
            else { s0 = mfma32(a0, qf[s4], s0); s1 = mfma32(a1, qf[s4], s1); }
        }
        const int kbase = 64 * kt + 4 * hl;
        const bool far = (MODE == MODE_WIN || MODE == MODE_SEL) ? (wtmin - (64 * kt + 63) >= 128) : false;
        const bool fmask = (MODE == MODE_FOX) ? (64 * kt + 63 > wtmin) : false;
        const bool clean = (MODE == MODE_WIN) ? (far && (wtmax - 64 * kt < W)) : false;
        const float mref = (MODE == MODE_CMP2) ? mfix : ((m == -INFINITY) ? 0.f : m);
        if (MODE == MODE_FOX) {
#pragma unroll
            for (int kb = 0; kb < 2; ++kb)
#pragma unroll
                for (int a = 0; a < 4; ++a) {
                    const f32x4 c4 = lds_ld<f32x4>(L + A_CB + buf * 256 + (32 * kb + 8 * a + 4 * hl) * 4);
#pragma unroll
                    for (int e = 0; e < 4; ++e) { const int r = 4 * a + e; if (kb) s1[r] = s1[r] * SC2 + c4[e]; else s0[r] = s0[r] * SC2 + c4[e]; }
                }
            if (__builtin_amdgcn_readfirstlane((int)fmask)) {
#pragma unroll
                for (int r = 0; r < 16; ++r) {
                    const int key = kbase + 8 * (r >> 2) + (r & 3);
                    if (key > t) s0[r] = -INFINITY;
                    if (key + 32 > t) s1[r] = -INFINITY;
                }
            }
        } else if (clean || (MODE == MODE_SEL && far)) {
            const float add = (MODE == MODE_SEL && !selbit) ? -INFINITY : tab128;
#pragma unroll
            for (int r = 0; r < 16; ++r) { s0[r] = s0[r] * SC2 + add; s1[r] = s1[r] * SC2 + add; }
        } else if (MODE == MODE_WIN || MODE == MODE_SEL) {
            const int dbase = t - kbase;
            const lptr tb = L + tabofs + (dbase + TAB0 - 63) * 4;
#pragma unroll
            for (int kb = 0; kb < 2; ++kb)
#pragma unroll
                for (int a = 0; a < 4; ++a)
#pragma unroll
                    for (int e = 0; e < 4; ++e) {
                        const int r = 4 * a + e, off = 32 * kb + 8 * a + e; const int d = dbase - off;
                        const float bsv = far ? tab128 : lds_ld<float>(tb + 4 * (63 - off));
                        const bool ok = (MODE == MODE_WIN) ? ((unsigned)d < (unsigned)W) : (selbit && d >= 0);
                        const float sv = kb ? s1[r] : s0[r];
                        const float x = ok ? sv * SC2 + bsv : -INFINITY;
                        if (kb) s1[r] = x; else s0[r] = x;
                    }
        } else if (wtmin - (16 * (64 * kt + 63) + 31) >= 128) {
#pragma unroll
            for (int r = 0; r < 16; ++r) { s0[r] = s0[r] * SC2 + tab128; s1[r] = s1[r] * SC2 + tab128; }
        } else {
#pragma unroll
            for (int kb = 0; kb < 2; ++kb)
#pragma unroll
                for (int a = 0; a < 4; ++a)
#pragma unroll
                    for (int e = 0; e < 4; ++e) {
                        const int r = 4 * a + e; const int key = kbase + 32 * kb + 8 * a + e; const int d = t - (16 * key + 31);
                        int di = d < 0 ? 0 : d; di = di > 128 ? 128 : di;
                        const float bsv = lds_ld<float>(L + tabofs + (di + TAB0) * 4);
                        const float sv = kb ? s1[r] : s0[r];
                        const float x = (d >= 0) ? sv * SC2 + bsv : -INFINITY;
                        if (kb) s1[r] = x; else s0[r] = x;
                    }
        }
        if (MODE != MODE_CMP2) {
            float mx = max3f(s0[0], s1[0], s0[1]);
#pragma unroll
            for (int r = 1; r < 15; r += 2) { mx = max3f(mx, s1[r], s0[r + 1]); mx = max3f(mx, s1[r + 1], (r + 2 < 16) ? s0[r + 2] : s1[r + 1]); }
            mx = fmaxf(mx, s1[15]);
            mx = half_max(mx);
            const bool minf = (m == -INFINITY);
            if (__any((mx > RESC_THR) || (minf && mx > -INFINITY))) {
                const float delta = minf ? ((mx == -INFINITY) ? 0.f : mx) : fmaxf(mx, 0.f);
                m = (minf && mx == -INFINITY) ? -INFINITY : mref + delta;
                { const float nm = (m == -INFINITY) ? 0.f : -m * (1.0f / SC2);
#pragma unroll
                  for (int r = 0; r < 16; ++r) negm[r] = nm; }
                const float alpha = minf ? 1.f : ex2(-delta);
                l *= alpha;
                if (MODE != MODE_CMP1) { o[0] = o[0] * alpha; o[1] = o[1] * alpha; }
#pragma unroll
                for (int r = 0; r < 16; ++r) { s0[r] -= delta; s1[r] -= delta; }
            }
            float ps = 0.f;
#pragma unroll
            for (int r = 0; r < 16; ++r) { s0[r] = ex2(s0[r]); s1[r] = ex2(s1[r]); ps += s0[r] + s1[r]; }
            l += ps;
        } else {
#pragma unroll
            for (int r = 0; r < 16; ++r) { s0[r] = ex2(s0[r]) * linv; s1[r] = ex2(s1[r]) * linv; }
            float quad[8], last[8], recv[8];
#pragma unroll
            for (int a = 0; a < 4; ++a) {
                quad[a] = (s0[4 * a] + s0[4 * a + 1]) + (s0[4 * a + 2] + s0[4 * a + 3]); last[a] = s0[4 * a + 3];
                quad[4 + a] = (s1[4 * a] + s1[4 * a + 1]) + (s1[4 * a + 2] + s1[4 * a + 3]); last[4 + a] = s1[4 * a + 3];
            }
#pragma unroll
            for (int i = 0; i < 8; ++i) recv[i] = half_other(last[i], hl);
#pragma unroll
            for (int i = 0; i < 8; ++i) {
                const float prev = (i > 0) ? recv[i > 0 ? i - 1 : 0] : carry;
                float v = quad[i] + (hl ? recv[i] : prev);
                v += __shfl_xor(v, 1); v += __shfl_xor(v, 2);
                if ((n & 3) == 0) lds_st<float>(L + score_ofs + (16 * kt + 2 * i + hl) * 4, v);
            }
            carry = recv[7];
        }
        if (MODE != MODE_CMP1) {
            bf16x8 pf[4];
#pragma unroll
            for (int ks = 0; ks < 4; ++ks) {
                const int hb = 8 * (ks & 1); u32x4 w;
                if (ks >> 1) { w.x = cvt_pk(s1[hb], s1[hb + 1]); w.y = cvt_pk(s1[hb + 2], s1[hb + 3]); w.z = cvt_pk(s1[hb + 4], s1[hb + 5]); w.w = cvt_pk(s1[hb + 6], s1[hb + 7]); }
                else { w.x = cvt_pk(s0[hb], s0[hb + 1]); w.y = cvt_pk(s0[hb + 2], s0[hb + 3]); w.z = cvt_pk(s0[hb + 4], s0[hb + 5]); w.w = cvt_pk(s0[hb + 6], s0[hb + 7]); }
                pf[ks] = __builtin_bit_cast(bf16x8, w);
            }
            const lptr vb_ = Vt + (4 * hl + q4) * VP + 32 * blk + 8 * p4;
#pragma unroll
            for (int c_ = 0; c_ < 2; ++c_)
#pragma unroll
                for (int ks_ = 0; ks_ < 4; ++ks_) {
                    const s16x4 lo_ = tr16(vb_ + (16 * ks_) * VP + 64 * c_), hi_ = tr16(vb_ + (16 * ks_ + 8) * VP + 64 * c_);
                    const bf16x8 vf_ = {lo_[0], lo_[1], lo_[2], lo_[3], hi_[0], hi_[1], hi_[2], hi_[3]};
                    o[c_] = mfma32(vf_, pf[ks_], o[c_]);
                }
        }
    }
}
template <int MODE, bool PRE>
__device__ __forceinline__ void attn_loop(lptr L, const AttnIO io, const unsigned long long umask, const bf16x8 (&qf)[4], const int t, const int wtmin, const int wtmax,
                                          const int tabofs, const int W, const unsigned mlo, const unsigned mhi, float& m, float& l, f32x16 (&o)[2],
                                          const float mfix, const float linv, const int score_ofs, const u32x4 pk = u32x4{}, const u32x4 pv = u32x4{}) {
    const int tid = otid(), lane = tid & 63;
    const int srow = tid >> 3, sch = tid & 7;
    if (umask == 0ull) return;
    int kt = __builtin_ctzll(umask); unsigned long long rem = umask & (umask - 1ull);
    u32x4 kA, vA, kB, vB; float cA = 0.f, cB = 0.f;
#define STAGE_LOAD(KT, KR, VR, CR) do { int gr_ = 64 * (KT) + srow; gr_ = gr_ > io.maxrow ? io.maxrow : gr_; const size_t off_ = (size_t)gr_ * io.pitch + sch * 8; \
        KR = *(const u32x4*)(io.K + off_); VR = *(const u32x4*)(io.V + off_); if (MODE == MODE_FOX) { if (tid < 64) CR = io.cg[64 * (KT) + tid]; } } while (0)
#define STAGE_STORE(B, VB, KR, VR, CR) do { lds_st<u32x4>(L + A_KT + (B) * 9216 + srow * KP + sch * 16, KR); lds_st<u32x4>(L + A_VT + (VB) * 12288 + srow * VP + sch * 16, VR); \
        if (MODE == MODE_FOX) { if (tid < 64) lds_st<float>(L + A_CB + (B) * 256 + tid * 4, CR); } } while (0)
#define NEXT_TILE(X) do { X = rem ? __builtin_ctzll(rem) : -1; rem &= rem - 1ull; } while (0)
    if (PRE) { kA = pk; vA = pv; } else { STAGE_LOAD(kt, kA, vA, cA); }
    STAGE_STORE(0, 0, kA, vA, cA);
    int nk, nnk; NEXT_TILE(nk);
    if (nk >= 0) STAGE_LOAD(nk, kA, vA, cA);
    __syncthreads();
    int buf = 0, vcur = 0, vnext = 1; float carry = 0.f;
    const float tab128 = (MODE == MODE_FOX) ? 0.f : lds_ld<float>(L + tabofs + (128 + TAB0) * 4);
    f32x16 negm;
    { const float nm0 = (MODE == MODE_CMP2) ? -mfix * (1.0f / SC2) : ((m == -INFINITY) ? 0.f : -m * (1.0f / SC2));
#pragma unroll
      for (int r = 0; r < 16; ++r) negm[r] = nm0; }
    for (;;) {
        NEXT_TILE(nnk);
        if (nnk >= 0) STAGE_LOAD(nnk, kB, vB, cB);
        attn_tile<MODE>(L, buf, vcur, kt, qf, t, wtmin, wtmax, tabofs, W, mlo, mhi, m, l, o, mfix, linv, score_ofs, carry, tab128, lane, negm);
        if (nk >= 0) STAGE_STORE(buf ^ 1, vnext, kA, vA, cA);
        __syncthreads();
        if (nk < 0) break;
        kt = nk; nk = nnk; buf ^= 1; vcur = vnext; vnext ^= 1;
        NEXT_TILE(nnk);
        if (nnk >= 0) STAGE_LOAD(nnk, kA, vA, cA);
        attn_tile<MODE>(L, buf, vcur, kt, qf, t, wtmin, wtmax, tabofs, W, mlo, mhi, m, l, o, mfix, linv, score_ofs, carry, tab128, lane, negm);
        if (nk >= 0) STAGE_STORE(buf ^ 1, vnext, kB, vB, cB);
        __syncthreads();
        if (nk < 0) break;
        kt = nk; nk = nnk; buf ^= 1; vcur = vnext; vnext ^= 1;
    }
#undef STAGE_LOAD
#undef STAGE_STORE
#undef NEXT_TILE
}
__device__ __forceinline__ void first_tile_load(const AttnIO io, const int kt, u32x4& pk, u32x4& pv) {
    const int tid = otid(), srow = tid >> 3, sch = tid & 7;
    int gr = 64 * kt + srow; gr = gr > io.maxrow ? io.maxrow : gr;
    const size_t off = (size_t)gr * io.pitch + sch * 8;
    pk = *(const u32x4*)(io.K + off); pv = *(const u32x4*)(io.V + off);
}
__device__ __forceinline__ unsigned long long tile_bits(int lo, int hi) {
    const unsigned long long up = (hi >= 63) ? ~0ull : ((1ull << (hi + 1)) - 1ull);
    return up & ~((1ull << lo) - 1ull);
}
__device__ __forceinline__ void store_o(bf16_t* orow, const f32x16 (&o)[2], float sc, int hl) {
#pragma unroll
    for (int c = 0; c < 2; ++c)
#pragma unroll
        for (int a = 0; a < 4; ++a) {
            u32x2 w; w.x = cvt_pk(o[c][4 * a] * sc, o[c][4 * a + 1] * sc); w.y = cvt_pk(o[c][4 * a + 2] * sc, o[c][4 * a + 3] * sc);
            *(u32x2*)(orow + 32 * c + 8 * a + 4 * hl) = w;
        }
}
__device__ __forceinline__ void stash_put(lptr st, int lane, const f32x16 (&o)[2], float sc) {
#pragma unroll
    for (int c = 0; c < 2; ++c)
#pragma unroll
        for (int a = 0; a < 4; ++a) {
            u32x2 w; w.x = cvt_pk(o[c][4 * a] * sc, o[c][4 * a + 1] * sc); w.y = cvt_pk(o[c][4 * a + 2] * sc, o[c][4 * a + 3] * sc);
            lds_st<u32x2>(st + ((c * 4 + a) * 64 + lane) * 8, w);
        }
}
__device__ __forceinline__ void stash_add(lptr st, int lane, f32x16 (&o)[2], float sc) {
#pragma unroll
    for (int c = 0; c < 2; ++c)
#pragma unroll
        for (int a = 0; a < 4; ++a) {
            const u32x2 w = lds_ld<u32x2>(st + ((c * 4 + a) * 64 + lane) * 8);
            o[c][4 * a] = o[c][4 * a] * sc + __uint_as_float(w.x << 16); o[c][4 * a + 1] = o[c][4 * a + 1] * sc + __uint_as_float(w.x & 0xffff0000u);
            o[c][4 * a + 2] = o[c][4 * a + 2] * sc + __uint_as_float(w.y << 16); o[c][4 * a + 3] = o[c][4 * a + 3] * sc + __uint_as_float(w.y & 0xffff0000u);
        }
}
__device__ __forceinline__ void store_o_rows(lptr st, int lane, const f32x16 (&o)[2], float sc, bf16_t* gbase, const int gq) {
    const int n = lane & 31, hl = lane >> 5;
#pragma unroll
    for (int c = 0; c < 2; ++c)
#pragma unroll
        for (int a = 0; a < 4; ++a) {
            u32x2 w; w.x = cvt_pk(o[c][4 * a] * sc, o[c][4 * a + 1] * sc); w.y = cvt_pk(o[c][4 * a + 2] * sc, o[c][4 * a + 3] * sc);
            lds_st<u32x2>(st + n * 128 + (((4 * c + a) ^ (n & 7)) * 16) + 8 * hl, w);
        }
#pragma unroll
    for (int i = 0; i < 4; ++i) {
        const int col = i * 8 + (lane >> 3), ch = lane & 7;
        const u32x4 v = lds_ld<u32x4>(st + col * 128 + ((ch ^ (col & 7)) * 16));
        bf16_t* g = gbase + (gq ? ((col >> 2) * 512 + (col & 3) * 64) : col * 512) + ch * 8;
        *(u32x4*)g = v;
    }
}
__device__ __forceinline__ void fox_unit(lptr L, const Params& P, int b, int h, int qb) {
    const int tid_ = otid(); const int lane = tid_ & 63, wave = tid_ >> 6, n = lane & 31, hl = lane >> 5;
    const bf16_t* Zb = (const bf16_t*)(P.ws + WS_BIG) + (size_t)b * SEQ * ZLD;
    const int wtmin = qb * 256 + 32 * wave, t = wtmin + n;
    bf16x8 qf[4];
    { const bf16_t* qrow = Zb + (size_t)t * ZLD + C_QC + h * 64 + 8 * hl;
#pragma unroll
      for (int s = 0; s < 4; ++s) qf[s] = *(const bf16x8*)(qrow + 16 * s); }
    const AttnIO io{Zb + C_KC + h * 64, Zb + C_VC + h * 64, ZLD, SEQ - 1, (const float*)(P.ws + WS_CUM) + (size_t)(b * 8 + h) * SEQ};
    float m = -INFINITY, l = 0.f; f32x16 o[2] = {};
    attn_loop<MODE_FOX, false>(L, io, tile_bits(0, 4 * qb + 3), qf, t, wtmin, wtmin + 31, 0, 0, 0u, 0u, m, l, o, 0.f, 0.f, 0);
    const float lt = half_sum(l);
    store_o_rows(L + A_STASH + wave * 4096, lane, o, lt > 0.f ? 1.f / lt : 0.f, (bf16_t*)(P.ws + WS_OC) + (size_t)(b * SEQ + wtmin) * 512 + h * 64, 0);
}
__device__ __forceinline__ void swa_unit(lptr L, const Params& P, int layer, int b, int g, int qi) {
    const int tid_ = otid(); const int lane = tid_ & 63, wave = tid_ >> 6, n = lane & 31, hl = lane >> 5;
    const bf16_t* Zb = (const bf16_t*)(P.ws + WS_BIG) + (size_t)b * SEQ * ZLD;
    const int wtmin = 64 * qi + 8 * wave, t = wtmin + (n >> 2), head = g * 4 + (n & 3);
    bf16x8 qf[4];
    { const bf16_t* qrow = Zb + (size_t)t * ZLD + C_QB + head * 64 + 8 * hl;
#pragma unroll
      for (int s = 0; s < 4; ++s) qf[s] = *(const bf16x8*)(qrow + 16 * s); }
    const AttnIO io{Zb + C_KB + g * 64, Zb + C_VB + g * 64, ZLD, SEQ - 1, nullptr};
    float m = -INFINITY, l = 0.f; f32x16 o[2] = {};
    attn_loop<MODE_WIN, false>(L, io, tile_bits(qi >= 2 ? qi - 2 : 0, qi), qf, t, wtmin, wtmin + 7, A_TAB + (8 + head) * TABP * 4, 128, 0u, 0u, m, l, o, 0.f, 0.f, 0);
    const float lt = half_sum(l);
    const float sink = P.in[13][layer * 8 + head] * LOG2E;
    const float mm = fmaxf(m, sink), f = ex2(m - mm), den = lt * f + ex2(sink - mm);
    store_o_rows(L + A_STASH + wave * 4096, lane, o, f / den, (bf16_t*)(P.ws + WS_OB) + (size_t)(b * SEQ + wtmin) * 512 + g * 256, 1);
}
__device__ __forceinline__ void nsa_unit(lptr L, const Params& P, int b, int g, int qi) {
    const int tid = otid(), lane = tid & 63, wave = tid >> 6, n = lane & 31, hl = lane >> 5;
    const bf16_t* Zb = (const bf16_t*)(P.ws + WS_BIG) + (size_t)b * SEQ * ZLD;
    const int wtmin = 64 * qi + 8 * wave, ql = n >> 2, t = wtmin + ql, head = g * 4 + (n & 3);
    const int tabofs = A_TAB + head * TABP * 4;
    bf16x8 qf[4];
    { const bf16_t* qrow = Zb + (size_t)t * ZLD + C_QA + head * 64 + 8 * hl;
#pragma unroll
      for (int s = 0; s < 4; ++s) qf[s] = *(const bf16x8*)(qrow + 16 * s); }
    float gc, gs, gwn;
    { const bf16_t* gp = Zb + (size_t)t * ZLD + C_GA + head * 3; gc = sigmoidf_(bf2f(gp[0])); gs = sigmoidf_(bf2f(gp[1])); gwn = sigmoidf_(bf2f(gp[2])); }
    const lptr stash = L + A_STASH + wave * 4096;
    const AttnIO ioC{(const bf16_t*)(P.ws + WS_KC) + (size_t)(0 * 16 + b * 2 + g) * 256 * 64, (const bf16_t*)(P.ws + WS_KC) + (size_t)(1 * 16 + b * 2 + g) * 256 * 64, 64, 255, nullptr};
    const AttnIO ioS{Zb + C_KSLC + g * 64, Zb + C_VSLC + g * 64, ZLD, SEQ - 1, nullptr};
    const AttnIO ioW{Zb + C_KWIN + g * 64, Zb + C_VWIN + g * 64, ZLD, SEQ - 1, nullptr};
    const int wlo = qi >= 8 ? qi - 8 : 0;
    u32x4 pkn, pvn;
    {
        const unsigned long long um = tile_bits(0, (4 * qi + 2) >> 6);
        float m = -INFINITY, l = 0.f; f32x16 o[2] = {};
        first_tile_load(ioC, 0, pkn, pvn);
        attn_loop<MODE_CMP1, false>(L, ioC, um, qf, t, wtmin, wtmin + 7, tabofs, 0, 0u, 0u, m, l, o, 0.f, 0.f, 0);
        const float lt = half_sum(l);
        const float linv = lt > 0.f ? 1.f / lt : 0.f, mfix = (m == -INFINITY) ? 0.f : m;
#pragma unroll
        for (int i = 0; i < 8; ++i) lds_st<float>(L + A_SCORE + wave * 2048 + (i * 64 + lane) * 4, 0.f);
        const u32x4 pk2 = pkn, pv2 = pvn;
        first_tile_load(ioS, 0, pkn, pvn);
        attn_loop<MODE_CMP2, true>(L, ioC, um, qf, t, wtmin, wtmin + 7, tabofs, 0, 0u, 0u, m, l, o, mfix, linv, A_SCORE + wave * 2048 + ql * 256, pk2, pv2);
        stash_put(stash, lane, o, gc);
    }
#pragma unroll 1
    for (int q = 0; q < 8; ++q) {
        const int tq = wtmin + q, cur = tq >> 6, J = lane;
        const bool elig = (J >= 1) && (J <= cur - 2);
        float v = lds_ld<float>(L + A_SCORE + wave * 2048 + (q * 64 + lane) * 4);
        v = elig ? v : -INFINITY;
        const int nfree = 8 - (cur == 0 ? 1 : (cur == 1 ? 2 : 3));
        unsigned long long picked = 0ull;
#pragma unroll 1
        for (int it = 0; it < nfree; ++it) {
            const float vv = ((picked >> J) & 1ull) ? -INFINITY : v;
            float mxv = vv;
#pragma unroll
            for (int o_ = 1; o_ < 32; o_ <<= 1) mxv = fmaxf(mxv, __shfl_xor(mxv, o_));
            mxv = half_max(mxv);
            const unsigned long long cand = __ballot(vv == mxv && vv > -INFINITY);
            if (cand == 0ull) break;
            picked |= 1ull << __builtin_ctzll(cand);
        }
        const bool sel = (((picked >> J) & 1ull) != 0ull) || (J == 0) || (J == cur) || (J == cur - 1);
        const unsigned long long bm = __ballot(sel);
        if (lane == 0) { lds_st<unsigned>(L + A_SELM + (wave * 8 + q) * 8, (unsigned)bm); lds_st<unsigned>(L + A_SELM + (wave * 8 + q) * 8 + 4, (unsigned)(bm >> 32)); }
    }
    __syncthreads();
    unsigned ulo = lds_ld<unsigned>(L + A_SELM + lane * 8), uhi = lds_ld<unsigned>(L + A_SELM + lane * 8 + 4);
#pragma unroll
    for (int o_ = 1; o_ < 64; o_ <<= 1) { ulo |= (unsigned)__shfl_xor((int)ulo, o_); uhi |= (unsigned)__shfl_xor((int)uhi, o_); }
    ulo = __builtin_amdgcn_readfirstlane(ulo); uhi = __builtin_amdgcn_readfirstlane(uhi);
    const unsigned mlo = lds_ld<unsigned>(L + A_SELM + (wave * 8 + ql) * 8), mhi = lds_ld<unsigned>(L + A_SELM + (wave * 8 + ql) * 8 + 4);
    {
        float m = -INFINITY, l = 0.f; f32x16 o[2] = {};
        const u32x4 pk3 = pkn, pv3 = pvn;
        first_tile_load(ioW, wlo, pkn, pvn);
        attn_loop<MODE_SEL, true>(L, ioS, ((unsigned long long)uhi << 32) | ulo, qf, t, wtmin, wtmin + 7, tabofs, 0, mlo, mhi, m, l, o, 0.f, 0.f, 0, pk3, pv3);
        const float lt = half_sum(l); const float sc = (lt > 0.f ? 1.f / lt : 0.f) * gs;
        stash_add(stash, lane, o, sc); stash_put(stash, lane, o, 1.f);
    }
    {
        float m = -INFINITY, l = 0.f; f32x16 o[2] = {};
        attn_loop<MODE_WIN, true>(L, ioW, tile_bits(wlo, qi), qf, t, wtmin, wtmin + 7, tabofs, 512, 0u, 0u, m, l, o, 0.f, 0.f, 0, pkn, pvn);
        const float lt = half_sum(l); const float sc = (lt > 0.f ? 1.f / lt : 0.f) * gwn;
        stash_add(stash, lane, o, sc);
        store_o_rows(stash, lane, o, 1.f, (bf16_t*)(P.ws + WS_OA) + (size_t)(b * SEQ + wtmin) * 512 + g * 256, 1);
    }
}
__device__ __forceinline__ void attn_phase(lptr L, const Params& P, int layer) {
    const int tid = otid(), G = gridDim.x;
    const int blk = (G % 8 == 0) ? (int)(blockIdx.x % 8) * (G / 8) + (int)(blockIdx.x / 8) : (int)blockIdx.x;
    for (int i = tid; i < 16 * TABP; i += NT) {
        const int h = i / TABP, d = i - h * TABP - TAB0;
        float v = 0.f;
        if (d >= 0) {
            int bk = d;
            if (d >= 16) { bk = (d >= 128) ? 31 : 16 + (int)(logf((float)d * (1.f / 16.f)) / logf(8.f) * 16.f); bk = bk > 31 ? 31 : bk; }
            v = P.in[1][bk * 16 + h] * LOG2E;
        }
        lds_st<float>(L + A_TAB + i * 4, v);
    }
    __syncthreads();
#pragma unroll 1
    for (int p = blk; p < 512; p += G) {
#pragma unroll 1
        for (int j = 0; j < 2; ++j) {
#ifdef DBG_NO_FOX
            continue;
#endif
            const int bh = p >> 3, s = p & 7; fox_unit(L, P, bh >> 3, bh & 7, j ? 15 - s : s);
#ifdef PROBE_FOX2
            fox_unit(L, P, bh >> 3, bh & 7, j ? 15 - s : s);
#endif
        }
    }
#pragma unroll 1
    for (int p = blk; p < 512; p += G) {
#pragma unroll 1
        for (int j = 0; j < 2; ++j) {
#ifdef DBG_NO_NSA
            continue;
#endif
            const int bg = p >> 5, s = p & 31;
#ifdef PROBE_NSA2
            for (int rep_ = 0; rep_ < 2; ++rep_)
#endif
            nsa_unit(L, P, bg >> 1, bg & 1, j ? 63 - s : s); }
    }
#pragma unroll 1
    for (int u = blk; u < 1024; u += G) {
#ifdef DBG_NO_SWA
        continue;
#endif
        const int bg = u >> 6; swa_unit(L, P, layer, bg >> 1, bg & 1, u & 63); }
}
__global__ void __launch_bounds__(NT, 2) mk_fwd(Params P) {
    __shared__ __attribute__((aligned(16))) unsigned char lds_raw[LDS_BYTES];
    const lptr L = (lptr)lds_raw;
    cg::grid_group grid = cg::this_grid();
    unsigned char* ws = P.ws;
    bf16_t* XN = (bf16_t*)(ws + WS_XN); bf16_t* BIG = (bf16_t*)(ws + WS_BIG);
    const int G = gridDim.x;
    if (otid() < 4) lds_st<unsigned>(L + A_XB + otid() * 4, 0u);
    __syncthreads();
    XcdBarrier xbar = xcd_barrier_post((unsigned*)(ws + WS_BAR), (volatile LAS unsigned*)(L + A_XB));
    prep_x(P);
#pragma unroll 1
    for (int l = 0; l < DEPTH; ++l) {
#pragma unroll 1
        for (int si = 0; si < 14; ++si) {
            const int st = (si <= 7) ? si : (si == 8 ? 13 : si - 1);
            const int bx = obid();
#ifdef DBG_SKIP_LO
            if (st >= DBG_SKIP_LO && st <= DBG_SKIP_HI) continue;
#endif
            if (st == 0) {
                prep_weights(L, P, l);
#ifdef PROBE_PREP2
                __syncthreads(); prep_weights(L, P, l);
#endif
            } else if (st == 1 || st == 10) {
                pg8::Gemm g{XN, (const bf16_t*)(ws + (st == 1 ? W_1A : W_1B)), M, 2 * DFF, DM}; pg8::StaticOrder S; S.init(M, 2 * DFF, G, bx);
                EpiSwiGLU E{BIG};
                pg8::gemm_phase<EpiSwiGLU, pg8::StaticOrder, true, true>((PG8_LAS unsigned char*)L, g, S, E);
#ifdef PROBE_UP2
                pg8::gemm_phase<EpiSwiGLU, pg8::StaticOrder, true, true>((PG8_LAS unsigned char*)L, g, S, E);
#endif
            } else if (st == 2 || st == 11 || st == 8) {
                const bf16_t* A = (st == 8) ? (const bf16_t*)(ws + WS_MRG) : BIG;
                const bf16_t* Bt = (const bf16_t*)(ws + (st == 8 ? W_O : (st == 2 ? W_2A : W_2B)));
                pg8::Gemm g{A, Bt, M, DM, st == 8 ? DM : DFF}; pg8::StaticOrder S; S.init(M, DM, G, bx);
                const float* eg = (st == 2) ? (l ? P.in[25] + (l - 1) * DM : nullptr) : (st == 8 ? P.in[2] + l * DM : P.in[21] + l * DM);
                const float* eb = (st == 2) ? (l ? P.in[26] + (l - 1) * DM : nullptr) : (st == 8 ? P.in[3] + l * DM : P.in[22] + l * DM);
                EpiResid E{P.out, (const float*)(ws + WS_STATS), eg, eb, ALPHA, st == 8 ? 1.0f : 0.5f};
                pg8::gemm_phase<EpiResid, pg8::StaticOrder, true, true>((PG8_LAS unsigned char*)L, g, S, E);
#ifdef PROBE_RESID2
                { EpiResid E2{P.out, (const float*)(ws + WS_STATS), nullptr, nullptr, 1.0f, 0.0f};
                  pg8::gemm_phase<EpiResid, pg8::StaticOrder, true, true>((PG8_LAS unsigned char*)L, g, S, E2); }
#endif
            } else if (st == 3 || st == 9 || st == 12) {
                const float* lg = st == 3 ? P.in[2] : (st == 9 ? P.in[21] : P.in[25]); const float* lb = st == 3 ? P.in[3] : (st == 9 ? P.in[22] : P.in[26]);
                ln_pass(P, lg + l * DM, lb + l * DM, l == DEPTH - 1 && st == 12);
            } else if (st == 4) {
                pg8::Gemm g{XN, (const bf16_t*)(ws + W_Z), M, 3840, DM}; pg8::StaticOrder S; S.init(M, 3840, G, bx);
                EpiZ E{BIG};
                pg8::gemm_phase<EpiZ, pg8::StaticOrder, true, true>((PG8_LAS unsigned char*)L, g, S, E);
#ifdef PROBE_Z2
                pg8::gemm_phase<EpiZ, pg8::StaticOrder, true, true>((PG8_LAS unsigned char*)L, g, S, E);
#endif
            } else if (st == 5) {
                compress_phase(L, P, l);
#ifdef PROBE_CMP2
                __syncthreads(); compress_phase(L, P, l);
#endif
            } else if (st == 6) {
                attn_phase(L, P, l);
#ifdef PROBE_ATTN2
                __syncthreads(); attn_phase(L, P, l);
#endif
            } else if (st == 7) {
                pg8::Gemm g{XN, (const bf16_t*)(ws + W_G), M, 3 * DM, DM}; pg8::StaticOrder S; S.init(M, 3 * DM, G, bx);
                EpiGate E{(bf16_t*)(ws + WS_GATE), P.in[19] + (size_t)l * 3 * DM};
                pg8::gemm_phase<EpiGate, pg8::StaticOrder, true, true>((PG8_LAS unsigned char*)L, g, S, E);
#ifdef PROBE_GATE2
                pg8::gemm_phase<EpiGate, pg8::StaticOrder, true, true>((PG8_LAS unsigned char*)L, g, S, E);
#endif
            } else if (st == 13) {
                pg8::Gemm g{(const bf16_t*)(ws + WS_OA), (const bf16_t*)(ws + W_BR), 3 * M, 3 * DM, 512}; MergeOrder S; S.base.init(M, DM, G, bx);
                EpiMerge E{(const bf16_t*)(ws + WS_GATE), (bf16_t*)(ws + WS_MRG)};
                pg8::gemm_phase<EpiMerge, MergeOrder, true, true>((PG8_LAS unsigned char*)L, g, S, E);
            }
            if (l == 0 && st == 0) grid.sync();
            xcd_barrier(xbar);
#ifdef PROBE_XB2
            xcd_barrier(xbar); xcd_barrier(xbar);
#endif
        }
    }
}
}

extern "C" void kernel_launch(void* const* d_in, const int* in_sizes, int n_in, void* d_out, int out_size, void* d_ws, size_t ws_size, hipStream_t stream) {
    static int grid = 0;
    if (grid == 0) {
        if (n_in != 27 || out_size != mk::M * mk::DM || ws_size < mk::WS_TOTAL) { fprintf(stderr, "kernel_launch: unexpected shapes (n_in %d, out %d, ws %zu)\n", n_in, out_size, ws_size); grid = -1; return; }
        int dev = 0, cus = 0, per_cu = 0;
        hipGetDevice(&dev); hipDeviceGetAttribute(&cus, hipDeviceAttributeMultiprocessorCount, dev);
        hipOccupancyMaxActiveBlocksPerMultiprocessor(&per_cu, (const void*)mk::mk_fwd, mk::NT, 0);
        if (per_cu < 1) { fprintf(stderr, "kernel_launch: occupancy query says %d blocks/CU\n", per_cu); per_cu = 1; }
        grid = cus * 1;
    }
    if (grid < 0) return;
    if (hipMemsetAsync((char*)d_ws + mk::WS_BAR, 0, 16384, stream) != hipSuccess) { fprintf(stderr, "memset failed\n"); return; }
    mk::Params p{};
    for (int i = 0; i < 27; ++i) p.in[i] = (const float*)d_in[i];
    p.out = (float*)d_out; p.ws = (unsigned char*)d_ws;
    void* args[] = {&p};
    hipError_t e = hipLaunchCooperativeKernel((const void*)mk::mk_fwd, dim3(grid), dim3(mk::NT), args, 0, stream);
    if (e != hipSuccess) fprintf(stderr, "cooperative launch failed: %s (grid %d)\n", hipGetErrorString(e), grid);
}
```

```cpp
#include <hip/hip_runtime.h>
#include <hip/hip_cooperative_groups.h>
#include <cstdio>
#include <cstdint>
namespace cg = cooperative_groups;
__device__ __forceinline__ int otid() { int t = threadIdx.x; asm volatile("" : "+v"(t)); return t; }
__device__ __forceinline__ int obid() { int t = blockIdx.x; asm volatile("" : "+s"(t)); return t; }
#ifndef PROBE_ST7N
#define PROBE_ST7N 1
#endif
namespace pg8 {
#define PG8_LAS __attribute__((address_space(3)))
typedef unsigned short bf16_t;
typedef short bf16x8 __attribute__((ext_vector_type(8)));
typedef float f32x4 __attribute__((ext_vector_type(4)));
typedef unsigned u32x4 __attribute__((ext_vector_type(4)));
constexpr int BM = 256, BK = 64, HALF = 128, HTB = HALF * BK * 2  , STAGE_BYTES = 8 * HTB, NXCD = 8, WGM = 4;

__host__ __device__ __forceinline__ int lds_byte(int r, int c) { const int st = (r >> 4) * 2 + (c >> 5), rr = r & 15, cc = c & 31, ob = rr * 64 + cc * 2; return st * 1024 + (ob ^ (((ob >> 9) & 1) << 5)); }
__host__ __device__ __forceinline__ void stage_rc(int b, int& R, int& C) { const int st = b / 1024, sb = b % 1024, swz = sb ^ (((sb >> 9) & 1) << 5); R = (st >> 1) * 16 + swz / 64; C = (st & 1) * 32 + (swz % 64) / 2; }
__host__ __device__ __forceinline__ int perm32(int rho) { const int n = rho >> 4, i = rho & 15; return 8 * (i >> 2) + 4 * n + (i & 3); }

struct Unit { int pm, pn; };
struct Gemm { const bf16_t* A; const bf16_t* Bt; int M, N, K; };

struct StaticOrder {
    int nM, nN, nwg, G, c;
    __host__ __device__ void init(int M, int N, int G_, int c_) { nM = M / BM; nN = N / BM; nwg = nM * nN; G = G_; c = c_; }
    __host__ __device__ bool next(int i, Unit& u) const {
        const long L = (long)i * G + c; if (L >= nwg) return false;
        int wgid = (int)L; { const int q = nwg / NXCD, r = nwg % NXCD, xcd = wgid % NXCD, off = wgid / NXCD; wgid = (xcd < r ? xcd * (q + 1) : r * (q + 1) + (xcd - r) * q) + off; }
        const int nig = WGM * nN, gid = wgid / nig, fm = gid * WGM, gsz = (nM - fm) < WGM ? (nM - fm) : WGM;
        u.pm = fm + ((wgid % nig) % gsz); u.pn = (wgid % nig) / gsz; return true;
    }
    __device__ __forceinline__ void a_ready(const Unit&) const {}
    __device__ __forceinline__ void done(const Unit&) const {}
};

__device__ __forceinline__ unsigned cvt_pk_bf16(float lo, float hi) { unsigned r; asm volatile("v_cvt_pk_bf16_f32 %0, %1, %2" : "=v"(r) : "v"(lo), "v"(hi)); return r; }
typedef float f32x2 __attribute__((ext_vector_type(2)));
__device__ __forceinline__ f32x2 gelu_pk(f32x2 v) {
    const f32x2 av = __builtin_elementwise_abs(v), d = av * 0.2316418882f + 1.0f;
    f32x2 t; t.x = __builtin_amdgcn_rcpf(d.x); t.y = __builtin_amdgcn_rcpf(d.y);
    f32x2 q = t * 0.5307027145f + (-0.7265760135f); q = q * t + 0.7107068705f; q = q * t + (-0.142248368f); q = q * t + 0.127414796f; q = q * t;
    const f32x2 s = (v * v) * (-0.72134752044f);
    f32x2 e; e.x = __builtin_amdgcn_exp2f(s.x); e.y = __builtin_amdgcn_exp2f(s.y);
    const f32x2 m = v * (q * e), r = v - m;
    f32x2 o; o.x = v.x < 0.f ? m.x : r.x; o.y = v.y < 0.f ? m.y : r.y; return o;
}

template <int ACT  > struct EpiBf16 {
    static constexpr bool PERM = true, AFTER_DRAIN = false, CARRY = false; static_assert(ACT == 0 || ACT == 1, "EpiBf16: ACT is 0 (none) or 1 (gelu_pk)");
    bf16_t* O; int ldc; const float* bias; int split_cols; size_t split_stride; float scale0;
    __device__ __forceinline__ void operator()(const f32x4 (&acc)[2][2][4][2], const Unit& u, int wr, int wc, int fr, int fq) const {
        const int row0 = u.pm * BM + wr * 64 + fr; int colt = u.pn * BM; bf16_t* base = O;
        float sc = 1.f; if (split_cols) { const int t = colt / split_cols; base += (size_t)t * split_stride; colt -= t * split_cols; if (t == 0) sc = scale0; }
        const int col0 = colt + wc * 32 + 8 * fq, bcol0 = u.pn * BM + wc * 32 + 8 * fq;
        f32x4 bv[2][2];
#pragma unroll
        for (int bj = 0; bj < 2; ++bj)
#pragma unroll
            for (int n = 0; n < 2; ++n) bv[bj][n] = bias ? *(const f32x4*)(bias + bcol0 + bj * HALF + 4 * n) : (f32x4){0.f, 0.f, 0.f, 0.f};
#pragma unroll
        for (int ai = 0; ai < 2; ++ai)
#pragma unroll
            for (int m = 0; m < 4; ++m) { bf16_t* rowp = base + (size_t)(row0 + ai * HALF + m * 16) * ldc + col0;
#pragma unroll
                for (int bj = 0; bj < 2; ++bj) { f32x4 v0 = acc[ai][bj][m][0] + bv[bj][0], v1 = acc[ai][bj][m][1] + bv[bj][1];
                    if (ACT == 1) { f32x2 a = gelu_pk((f32x2){v0[0], v0[1]}), b = gelu_pk((f32x2){v0[2], v0[3]}), c = gelu_pk((f32x2){v1[0], v1[1]}), d = gelu_pk((f32x2){v1[2], v1[3]});
                        v0 = (f32x4){a.x, a.y, b.x, b.y}; v1 = (f32x4){c.x, c.y, d.x, d.y}; }
                    v0 = v0 * sc; v1 = v1 * sc; u32x4 w; w.x = cvt_pk_bf16(v0[0], v0[1]); w.y = cvt_pk_bf16(v0[2], v0[3]); w.z = cvt_pk_bf16(v1[0], v1[1]); w.w = cvt_pk_bf16(v1[2], v1[3]);
                    *(u32x4*)(rowp + bj * HALF) = w; } }
    }
};
template <class Epi, class Sched, bool ALIGN_EPI = false, bool SP2 = false>
__device__ __forceinline__ void gemm_phase(PG8_LAS unsigned char* lds, const Gemm g, const Sched& S, const Epi& E) {
    const int tid = otid(), wid = __builtin_amdgcn_readfirstlane(tid >> 6), lane = tid & 63, wr = wid >> 2, wc = wid & 3, fr = lane & 15, fq = lane >> 4;
    const int K = g.K, nt = K / BK;
    unsigned voffA[2], voffB[2];
#pragma unroll
    for (int i = 0; i < 2; ++i) { int R, C; stage_rc(tid * 16 + i * 8192, R, C); const int Rb = Epi::PERM ? ((R & ~31) + perm32(R & 31)) : R;
        voffA[i] = (unsigned)(R * K + C) * 2u; voffB[i] = (unsigned)(Rb * K + C) * 2u; }
    const size_t kstep = (size_t)(BK * 2);
    const size_t hstep = (size_t)HALF * K * 2;
    const size_t tstep = 2 * hstep;
    const unsigned ldsw = (unsigned)wid * 1024u;
    const int aoff = lds_byte(wr * 64 + fr, fq * 8), boff = lds_byte(wc * 32 + fr, fq * 8);
#define PG8_SA(b, h) (((b) * 2 + (h)) * HTB)
#define PG8_SB(b, h) ((4 + (b) * 2 + (h)) * HTB)
#define PG8_STAGE(bufoff, gbase, voff) do { _Pragma("unroll") for (int _i = 0; _i < 2; ++_i) \
        __builtin_amdgcn_global_load_lds((const unsigned*)((const char*)(gbase) + (voff)[_i]), (PG8_LAS unsigned*)(lds + (bufoff) + ldsw + _i * 8192), 16, 0, 0); } while (0)
#define PG8_LDA(dst, b, h) do { _Pragma("unroll") for (int m = 0; m < 4; ++m) _Pragma("unroll") for (int k = 0; k < 2; ++k) dst[m][k] = *(const PG8_LAS bf16x8*)(lds + PG8_SA(b, h) + aoff + m * 2048 + k * 1024); } while (0)
#define PG8_LDB(dst, b, h) do { _Pragma("unroll") for (int n = 0; n < 2; ++n) _Pragma("unroll") for (int k = 0; k < 2; ++k) dst[n][k] = *(const PG8_LAS bf16x8*)(lds + PG8_SB(b, h) + boff + n * 2048 + k * 1024); } while (0)
#define PG8_MMA(ai, bj, At, Bt) do { __builtin_amdgcn_s_setprio(1); _Pragma("unroll") for (int m = 0; m < 4; ++m) _Pragma("unroll") for (int n = 0; n < 2; ++n) _Pragma("unroll") for (int k = 0; k < 2; ++k) \
        acc[ai][bj][m][n] = __builtin_amdgcn_mfma_f32_16x16x32_bf16(Bt[n][k], At[m][k], acc[ai][bj][m][n], 0, 0, 0); __builtin_amdgcn_s_setprio(0); } while (0)
#define PG8_WAIT_V(n) asm volatile("s_waitcnt vmcnt(" #n ")" ::: "memory")
#define PG8_WAIT_L(n) asm volatile("s_waitcnt lgkmcnt(" #n ")" ::: "memory")
#define PG8_BAR __builtin_amdgcn_s_barrier()
#define PG8_SCHED __builtin_amdgcn_sched_barrier(0)
    Unit cur, nxt; int ui = 0;
    if (!S.next(0, cur)) return;
    f32x4 acc[2][2][4][2];
#pragma unroll
    for (int a = 0; a < 2; ++a)
#pragma unroll
        for (int b = 0; b < 2; ++b)
#pragma unroll
            for (int m = 0; m < 4; ++m)
#pragma unroll
                for (int n = 0; n < 2; ++n) acc[a][b][m][n] = (f32x4){0.f, 0.f, 0.f, 0.f};
    bf16x8 At[4][2], B0[2][2], B1[2][2];
    const char* cA = (const char*)g.A + (size_t)cur.pm * tstep; const char* cB = (const char*)g.Bt + (size_t)cur.pn * tstep;
    S.a_ready(cur);
    if constexpr (SP2) {
        PG8_STAGE(PG8_SB(0, 0), cB, voffB); PG8_STAGE(PG8_SB(0, 1), cB + hstep, voffB); PG8_STAGE(PG8_SA(0, 0), cA, voffA); PG8_STAGE(PG8_SA(0, 1), cA + hstep, voffA);
        if (wr == 1) PG8_BAR;
        PG8_WAIT_V(2); PG8_BAR;
        PG8_STAGE(PG8_SB(1, 0), cB + kstep, voffB); PG8_STAGE(PG8_SA(1, 0), cA + kstep, voffA); PG8_STAGE(PG8_SB(1, 1), cB + hstep + kstep, voffB);
        PG8_WAIT_V(6); PG8_BAR;
    } else {
        PG8_STAGE(PG8_SB(0, 0), cB, voffB); PG8_STAGE(PG8_SA(0, 0), cA, voffA); PG8_STAGE(PG8_SB(0, 1), cB + hstep, voffB); PG8_STAGE(PG8_SA(0, 1), cA + hstep, voffA);
        if (wr == 1) PG8_BAR;
        PG8_WAIT_V(4); PG8_BAR;
        PG8_STAGE(PG8_SB(1, 0), cB + kstep, voffB); PG8_STAGE(PG8_SA(1, 0), cA + kstep, voffA); PG8_STAGE(PG8_SB(1, 1), cB + hstep + kstep, voffB);
        PG8_WAIT_V(6); PG8_BAR;
    }
    for (;;) {
        const bool has_next = S.next(ui + 1, nxt);
        const char* nA = has_next ? (const char*)g.A + (size_t)nxt.pm * tstep : cA; const char* nB = has_next ? (const char*)g.Bt + (size_t)nxt.pn * tstep : cB;
        for (int t = 0; t < nt; t += 2) {
            const bool last = (t == nt - 2);
            const char* a1 = cA + (size_t)(t + 1) * kstep;
            const char* a2 = last ? nA : cA + (size_t)(t + 2) * kstep; const char* b2 = last ? nB : cB + (size_t)(t + 2) * kstep;
            const char* a3 = a2 + kstep; const char* b3 = b2 + kstep;
            if (last && has_next) S.a_ready(nxt);
            if constexpr (SP2) {
            PG8_LDB(B0, 0, 0); PG8_LDB(B1, 0, 1); PG8_SCHED; PG8_LDA(At, 0, 0); PG8_STAGE(PG8_SA(1, 1), a1 + hstep, voffA);
            PG8_WAIT_V(8); PG8_WAIT_L(0); PG8_BAR; PG8_MMA(0, 0, At, B0); PG8_MMA(0, 1, At, B1); PG8_BAR; PG8_SCHED;
            PG8_LDA(At, 0, 1); PG8_STAGE(PG8_SB(0, 0), b2, voffB); PG8_STAGE(PG8_SB(0, 1), b2 + hstep, voffB); PG8_STAGE(PG8_SA(0, 0), a2, voffA);
            PG8_WAIT_V(8); PG8_WAIT_L(0); PG8_BAR; PG8_MMA(1, 0, At, B0); PG8_MMA(1, 1, At, B1); PG8_BAR; PG8_SCHED;
            PG8_LDB(B0, 1, 0); PG8_LDB(B1, 1, 1); PG8_SCHED; PG8_LDA(At, 1, 0); PG8_STAGE(PG8_SA(0, 1), a2 + hstep, voffA);
            PG8_WAIT_V(8); PG8_WAIT_L(0); PG8_BAR; PG8_MMA(0, 0, At, B0); PG8_MMA(0, 1, At, B1); PG8_BAR; PG8_SCHED;
            PG8_LDA(At, 1, 1); PG8_STAGE(PG8_SB(1, 0), b3, voffB); PG8_STAGE(PG8_SB(1, 1), b3 + hstep, voffB); PG8_STAGE(PG8_SA(1, 0), a3, voffA);
            PG8_WAIT_V(8); PG8_WAIT_L(0); PG8_BAR; PG8_MMA(1, 0, At, B0); PG8_MMA(1, 1, At, B1); PG8_BAR; PG8_SCHED;
            } else {
            PG8_LDB(B0, 0, 0); PG8_SCHED; PG8_LDA(At, 0, 0); PG8_STAGE(PG8_SA(1, 1), a1 + hstep, voffA);
            PG8_WAIT_L(8); PG8_BAR; PG8_WAIT_L(0); PG8_MMA(0, 0, At, B0); PG8_BAR; PG8_SCHED;
            PG8_LDB(B1, 0, 1); PG8_STAGE(PG8_SB(0, 0), b2, voffB);
            PG8_BAR; PG8_WAIT_L(0); PG8_MMA(0, 1, At, B1); PG8_BAR;
            PG8_LDA(At, 0, 1); PG8_STAGE(PG8_SA(0, 0), a2, voffA);
            PG8_BAR; PG8_WAIT_L(0); PG8_MMA(1, 0, At, B0); PG8_BAR; PG8_SCHED;
            PG8_STAGE(PG8_SB(0, 1), b2 + hstep, voffB);
            PG8_WAIT_V(6); PG8_BAR; PG8_MMA(1, 1, At, B1); PG8_BAR;
            PG8_LDB(B0, 1, 0); PG8_SCHED; PG8_LDA(At, 1, 0); PG8_STAGE(PG8_SA(0, 1), a2 + hstep, voffA);
            PG8_WAIT_L(8); PG8_BAR; PG8_WAIT_L(0); PG8_MMA(0, 0, At, B0); PG8_BAR; PG8_SCHED;
            PG8_LDB(B1, 1, 1); PG8_STAGE(PG8_SB(1, 0), b3, voffB);
            PG8_BAR; PG8_WAIT_L(0); PG8_MMA(0, 1, At, B1); PG8_BAR;
            PG8_LDA(At, 1, 1); PG8_STAGE(PG8_SA(1, 0), a3, voffA);
            PG8_BAR; PG8_WAIT_L(0); PG8_MMA(1, 0, At, B0); PG8_BAR; PG8_SCHED;
            PG8_STAGE(PG8_SB(1, 1), b3 + hstep, voffB);
            PG8_WAIT_V(6); PG8_BAR; PG8_MMA(1, 1, At, B1); PG8_BAR;
            }
        }
        if constexpr (ALIGN_EPI) { if (wr == 0) PG8_BAR; }
        bool keep_acc = false;
        if constexpr (!Epi::AFTER_DRAIN) { if constexpr (Epi::CARRY) keep_acc = E.carry(acc, cur, wr, wc, fr, fq); else E(acc, cur, wr, wc, fr, fq); S.done(cur); }
        if (!has_next) break;
        if (!keep_acc)
#pragma unroll
        for (int a = 0; a < 2; ++a)
#pragma unroll
            for (int b = 0; b < 2; ++b)
#pragma unroll
                for (int m = 0; m < 4; ++m)
#pragma unroll
                    for (int n = 0; n < 2; ++n) acc[a][b][m][n] = (f32x4){0.f, 0.f, 0.f, 0.f};
        cur = nxt; cA = nA; cB = nB; ++ui;
        if constexpr (ALIGN_EPI) { if (wr == 1) PG8_BAR; }
    }
    PG8_WAIT_V(0);
    if constexpr (!ALIGN_EPI) { if (wr == 0) PG8_BAR; }
    PG8_BAR;
    if constexpr (Epi::AFTER_DRAIN) { E.fused(acc, cur, wr, wc, fr, fq, lds, wid, lane); S.done(cur); }
#undef PG8_SA
#undef PG8_SB
#undef PG8_STAGE
#undef PG8_LDA
#undef PG8_LDB
#undef PG8_MMA
#undef PG8_WAIT_V
#undef PG8_WAIT_L
#undef PG8_BAR
#undef PG8_SCHED
}
}
namespace mk {
using pg8::bf16_t; using pg8::bf16x8; using pg8::f32x4; using pg8::u32x4; using pg8::Unit;
#define LAS __attribute__((address_space(3)))
typedef LAS unsigned char* lptr;
typedef float f32x16 __attribute__((ext_vector_type(16)));
typedef short s16x4 __attribute__((ext_vector_type(4)));
typedef unsigned u32x2 __attribute__((ext_vector_type(2)));
template <class T> __device__ __forceinline__ T lds_ld(lptr p) { return *(const LAS T*)p; }
template <class T> __device__ __forceinline__ void lds_st(lptr p, T v) { *(LAS T*)p = v; }

constexpr int BATCH = 8, SEQ = 4096, DM = 1024, DEPTH = 4, M = BATCH * SEQ, DFF = 2816, ZLD = 3616, NT = 512;
constexpr int C_QA = 0, C_KCMP = 512, C_VCMP = 640, C_KSLC = 768, C_VSLC = 896, C_KWIN = 1024, C_VWIN = 1152, C_GA = 1280, C_QB = 1304, C_KB = 1816, C_VB = 1944,
              C_QC = 2072, C_KC = 2584, C_VC = 3096, C_FC = 3608;
constexpr float ALPHA = 1.6817928305074290f, LOG2E = 1.4426950408889634f, LN_EPS = 1e-5f;
constexpr size_t MiB = 1u << 20;
constexpr size_t W_1A = 0, W_2A = W_1A + 11534336, W_Z = W_2A + 5767168, W_G = W_Z + 7864320, W_BR = W_G + 6291456, W_O = W_BR + 3145728, W_1B = W_O + 2097152,
                 W_2B = W_1B + 11534336, W_C1 = W_2B + 5767168, W_C2 = W_C1 + 2097152, W_PEB = W_C2 + 65536, W_END = W_PEB + 65536;
static_assert(W_END <= 54 * MiB, "weights region");
constexpr size_t WS_XN = 54 * MiB, WS_BIG = 118 * MiB, WS_GATE = WS_BIG, WS_MRG = WS_XN, WS_OA = 344 * MiB, WS_OB = 376 * MiB, WS_OC = 408 * MiB,
                 WS_KC = 440 * MiB, WS_CUM = 441 * MiB, WS_BAR = 442 * MiB, WS_STATS = 443 * MiB, WS_TOTAL = 444 * MiB;
static_assert((size_t)M * ZLD * 2 <= 226 * MiB, "Z fits");
constexpr int LDS_BYTES = 144 * 1024;
constexpr int A_KT = 0, A_VT = 18432, A_CB = 43008, A_SCORE = 43520, A_SELM = 59904, A_STASH = 60416, A_TAB = 93184, A_XB = 140000, KP = 144, VP = 192;

struct Params { const float* in[27]; float* out; unsigned char* ws; };

typedef float f32x2_t __attribute__((ext_vector_type(2))); typedef __bf16 bf16x2_t __attribute__((ext_vector_type(2)));
__device__ __forceinline__ unsigned cvt_pk(float lo, float hi) { f32x2_t v = {lo, hi}; bf16x2_t b = __builtin_convertvector(v, bf16x2_t); return __builtin_bit_cast(unsigned, b); }
__device__ __forceinline__ float bf2f(bf16_t v) { return __uint_as_float((unsigned)v << 16); }
__device__ __forceinline__ float ex2(float x) { return __builtin_amdgcn_exp2f(x); }
__device__ __forceinline__ float sigmoidf_(float x) { return __builtin_amdgcn_rcpf(1.0f + ex2(-x * LOG2E)); }
__device__ __forceinline__ f32x16 mfma32(bf16x8 a, bf16x8 b, f32x16 c) { return __builtin_amdgcn_mfma_f32_32x32x16_bf16(a, b, c, 0, 0, 0); }
__device__ __forceinline__ float wave_sum(float v) {
#pragma unroll
    for (int o = 1; o < 64; o <<= 1) v += __shfl_xor(v, o);
    return v;
}

struct EpiSwiGLU {
    static constexpr bool PERM = true, AFTER_DRAIN = false, CARRY = false; bf16_t* H;
    __device__ __forceinline__ void operator()(const f32x4 (&acc)[2][2][4][2], const Unit& u, int wr, int wc, int fr, int fq) const {
        const int row0 = u.pm * 256 + wr * 64 + fr, col0 = u.pn * 128 + wc * 32 + 8 * fq;
#pragma unroll
        for (int ai = 0; ai < 2; ++ai)
#pragma unroll
            for (int m = 0; m < 4; ++m) {
                bf16_t* rowp = H + (size_t)(row0 + ai * 128 + m * 16) * DFF + col0;
                float h[8];
#pragma unroll
                for (int n = 0; n < 2; ++n)
#pragma unroll
                    for (int e = 0; e < 4; ++e) { const float g = acc[ai][0][m][n][e], up = acc[ai][1][m][n][e]; h[n * 4 + e] = g * sigmoidf_(g) * up; }
                u32x4 w; w.x = cvt_pk(h[0], h[1]); w.y = cvt_pk(h[2], h[3]); w.z = cvt_pk(h[4], h[5]); w.w = cvt_pk(h[6], h[7]);
                *(u32x4*)rowp = w;
            }
    }
};
struct EpiResid {
    static constexpr bool PERM = true, AFTER_DRAIN = false, CARRY = false; float* X; const float* stats; const float* lng; const float* lnb; float ca, cb;
    __device__ __forceinline__ void operator()(const f32x4 (&acc)[2][2][4][2], const Unit& u, int wr, int wc, int fr, int fq) const {
        const int row0 = u.pm * 256 + wr * 64 + fr, col0 = u.pn * 256 + wc * 32 + 8 * fq;
#pragma unroll
        for (int bj = 0; bj < 2; ++bj) {
            const int c = col0 + bj * 128;
            f32x4 g0 = {1.f, 1.f, 1.f, 1.f}, g1 = g0, b0 = {0.f, 0.f, 0.f, 0.f}, b1 = b0;
            if (lng) { g0 = *(const f32x4*)(lng + c); g1 = *(const f32x4*)(lng + c + 4); b0 = *(const f32x4*)(lnb + c); b1 = *(const f32x4*)(lnb + c + 4); }
            g0 = g0 * ca; g1 = g1 * ca; b0 = b0 * ca; b1 = b1 * ca;
#pragma unroll
            for (int ai = 0; ai < 2; ++ai)
#pragma unroll
                for (int m = 0; m < 4; ++m) {
                    const int row = row0 + ai * 128 + m * 16;
                    float mean = 0.f, rstd = 1.f;
                    if (lng) { const float2 st = *(const float2*)(stats + 2 * (size_t)row); mean = st.x; rstd = st.y; }
                    float* p = X + (size_t)row * DM + c;
                    f32x4 x0 = *(const f32x4*)p, x1 = *(const f32x4*)(p + 4);
                    x0 = (x0 - mean) * rstd * g0 + b0 + acc[ai][bj][m][0] * cb; x1 = (x1 - mean) * rstd * g1 + b1 + acc[ai][bj][m][1] * cb;
                    *(f32x4*)p = x0; *(f32x4*)(p + 4) = x1;
                    if (m & 1) asm volatile("" ::: "memory");
                }
        }
    }
};
struct EpiZ {
    static constexpr bool PERM = true, AFTER_DRAIN = false, CARRY = false; bf16_t* Z;
    __device__ __forceinline__ void operator()(const f32x4 (&acc)[2][2][4][2], const Unit& u, int wr, int wc, int fr, int fq) const {
        const int row0 = u.pm * 256 + wr * 64 + fr, col0 = u.pn * 256 + wc * 32 + 8 * fq;
#pragma unroll
        for (int ai = 0; ai < 2; ++ai)
#pragma unroll
            for (int m = 0; m < 4; ++m)
#pragma unroll
                for (int bj = 0; bj < 2; ++bj) {
                    const int c = col0 + bj * 128;
                    if (c < ZLD) {
                        const f32x4 v0 = acc[ai][bj][m][0], v1 = acc[ai][bj][m][1];
                        u32x4 w; w.x = cvt_pk(v0[0], v0[1]); w.y = cvt_pk(v0[2], v0[3]); w.z = cvt_pk(v1[0], v1[1]); w.w = cvt_pk(v1[2], v1[3]);
                        *(u32x4*)(Z + (size_t)(row0 + ai * 128 + m * 16) * ZLD + c) = w;
                    }
                }
    }
};
struct EpiGate {
    static constexpr bool PERM = true, AFTER_DRAIN = false, CARRY = false; bf16_t* G; const float* bias;
    __device__ __forceinline__ void operator()(const f32x4 (&acc)[2][2][4][2], const Unit& u, int wr, int wc, int fr, int fq) const {
        const int row0 = u.pm * 256 + wr * 64 + fr, col0 = u.pn * 256 + wc * 32 + 8 * fq;
#pragma unroll
        for (int bj = 0; bj < 2; ++bj) {
            const int c = col0 + bj * 128;
            const f32x4 b0 = *(const f32x4*)(bias + c), b1 = *(const f32x4*)(bias + c + 4);
#pragma unroll
            for (int ai = 0; ai < 2; ++ai)
#pragma unroll
                for (int m = 0; m < 4; ++m) {
                    const f32x4 v0 = acc[ai][bj][m][0] + b0, v1 = acc[ai][bj][m][1] + b1;
                    u32x4 w; w.x = cvt_pk(sigmoidf_(v0[0]), sigmoidf_(v0[1])); w.y = cvt_pk(sigmoidf_(v0[2]), sigmoidf_(v0[3]));
                    w.z = cvt_pk(sigmoidf_(v1[0]), sigmoidf_(v1[1])); w.w = cvt_pk(sigmoidf_(v1[2]), sigmoidf_(v1[3]));
                    *(u32x4*)(G + (size_t)(row0 + ai * 128 + m * 16) * (3 * DM) + c) = w;
                }
        }
    }
};
struct EpiMerge {
    static constexpr bool PERM = true, AFTER_DRAIN = false, CARRY = true; const bf16_t* G; bf16_t* Mg;
    __device__ __forceinline__ bool carry(f32x4 (&acc)[2][2][4][2], const Unit& u, int wr, int wc, int fr, int fq) const {
        const int br = u.pn >> 2, pm = u.pm - 128 * br, pn = u.pn & 3;
        const int row0 = pm * 256 + wr * 64 + fr, col0 = pn * 256 + wc * 32 + 8 * fq;
#pragma unroll
        for (int ai = 0; ai < 2; ++ai)
#pragma unroll
            for (int m = 0; m < 4; ++m)
#pragma unroll
                for (int bj = 0; bj < 2; ++bj) {
                    const size_t row = (size_t)(row0 + ai * 128 + m * 16); const int c = col0 + bj * 128;
                    const u32x4 gn = *(const u32x4*)(G + row * (3 * DM) + br * DM + c);
                    float f[8];
#pragma unroll
                    for (int j = 0; j < 4; ++j) { f[2 * j] = __uint_as_float(gn[j] << 16); f[2 * j + 1] = __uint_as_float(gn[j] & 0xffff0000u); }
                    if (br < 2) {
                        const u32x4 gd = *(const u32x4*)(G + row * (3 * DM) + (br + 1) * DM + c);
#pragma unroll
                        for (int j = 0; j < 4; ++j) {
                            f[2 * j] *= __builtin_amdgcn_rcpf(fmaxf(__uint_as_float(gd[j] << 16), 1e-30f));
                            f[2 * j + 1] *= __builtin_amdgcn_rcpf(fmaxf(__uint_as_float(gd[j] & 0xffff0000u), 1e-30f));
                        }
#pragma unroll
                        for (int i = 0; i < 8; ++i) acc[ai][bj][m][i >> 2][i & 3] *= f[i];
                    } else {
                        float v[8];
#pragma unroll
                        for (int i = 0; i < 8; ++i) v[i] = acc[ai][bj][m][i >> 2][i & 3] * f[i];
                        u32x4 w; w.x = cvt_pk(v[0], v[1]); w.y = cvt_pk(v[2], v[3]); w.z = cvt_pk(v[4], v[5]); w.w = cvt_pk(v[6], v[7]);
                        *(u32x4*)(Mg + row * DM + c) = w;
                    }
                }
        return br < 2;
    }
};
struct MergeOrder {
    pg8::StaticOrder base;
    __device__ __forceinline__ bool next(int i, Unit& u) const { Unit t; if (!base.next(i / 3, t)) return false; const int br = i % 3; u.pm = t.pm + 128 * br; u.pn = t.pn + 4 * br; return true; }
    __device__ __forceinline__ void a_ready(const Unit&) const {}
    __device__ __forceinline__ void done(const Unit&) const {}
};
#define XB_TMO      128
#define XB_XCNT(j)  (256  + 64 * (j))
#define XB_XSUB(j)  (1280 + 64 * (j))
#define XB_XGEN(j)  (2304 + 64 * (j))
#define XB_TOP      3328
#define XB_TOPGEN   3392
#define XCD_BAR_WORDS 3456
#define XB_SPIN_CAP (1u << 18)

__device__ __forceinline__ unsigned xb_ld(unsigned* p)              { return __hip_atomic_load(p, __ATOMIC_RELAXED, __HIP_MEMORY_SCOPE_AGENT); }
__device__ __forceinline__ unsigned xb_add(unsigned* p, unsigned v) { return __hip_atomic_fetch_add(p, v, __ATOMIC_RELAXED, __HIP_MEMORY_SCOPE_AGENT); }
__device__ __forceinline__ unsigned xb_xcc_id() { return (unsigned)__builtin_amdgcn_s_getreg((3 << 11) | 20) & 0xFu; }
#define XB_SPIN(cond, bar) do { unsigned _sp = 0; while (cond) { __builtin_amdgcn_s_sleep(1); \
    if ((++_sp & 255u) == 0u) { if (xb_ld(&(bar)[XB_TMO])) break; if (_sp > XB_SPIN_CAP) { atomicAdd(&(bar)[XB_TMO], 1u); break; } } } } while (0)

struct XcdBarrier {
    unsigned* bar; unsigned x;
    volatile LAS unsigned* st;
};

__device__ __forceinline__ XcdBarrier xcd_barrier_post(unsigned* bar, volatile LAS unsigned* st) {
    XcdBarrier b; b.bar = bar; b.x = xb_xcc_id(); b.st = st;
    if (threadIdx.x == 0) (void)xb_add(&bar[XB_XCNT(b.x)], 1u);
    return b;
}
__device__ __forceinline__ void xcd_barrier_complete(unsigned* bar, unsigned x, unsigned& nloc, unsigned& nx) {
    const unsigned G = gridDim.x * gridDim.y * gridDim.z;
    unsigned sum, cnt, mine, sp = 0u;
    for (;;) {
        sum = 0u; cnt = 0u; mine = 0u;
#pragma unroll
        for (unsigned j = 0; j < 16; ++j) { const unsigned c = xb_ld(&bar[XB_XCNT(j)]); sum += c; cnt += (c > 0u) ? 1u : 0u; mine = (j == x) ? c : mine; }
        if (sum == G) break;
        __builtin_amdgcn_s_sleep(1);
        if ((++sp & 255u) == 0u) { if (xb_ld(&bar[XB_TMO])) break; if (sp > XB_SPIN_CAP) { atomicAdd(&bar[XB_TMO], 1u); break; } }
    }
    nloc = mine > 0u ? mine : 1u; nx = cnt > 0u ? cnt : 1u;
}

__device__ __forceinline__ void xcd_barrier(const XcdBarrier& b) {
    asm volatile("s_waitcnt vmcnt(0)" ::: "memory");
    __syncthreads();
    if (threadIdx.x == 0) {
        unsigned* bar = b.bar;
        __builtin_amdgcn_s_waitcnt(0);
        unsigned nloc = b.st[0], nx = b.st[1];
        if (nloc == 0u) { xcd_barrier_complete(bar, b.x, nloc, nx); b.st[0] = nloc; b.st[1] = nx; }
        const unsigned old = xb_add(&bar[XB_XSUB(b.x)], 1u);
        const unsigned gen = old / nloc;
        if (old + 1u == (gen + 1u) * nloc) {
            __builtin_amdgcn_fence(__ATOMIC_RELEASE, "agent");
            asm volatile("s_waitcnt vmcnt(0)" ::: "memory");
            const unsigned og = xb_add(&bar[XB_TOP], 1u);
            const unsigned tg = og / nx;
            if (og + 1u == (tg + 1u) * nx) xb_add(&bar[XB_TOPGEN], 1u);
            else XB_SPIN(xb_ld(&bar[XB_TOPGEN]) == tg, bar);
            __builtin_amdgcn_fence(__ATOMIC_ACQUIRE, "agent");
            xb_add(&bar[XB_XGEN(b.x)], 1u);
            asm volatile("s_waitcnt vmcnt(0)" ::: "memory");
        } else {
            XB_SPIN(xb_ld(&bar[XB_XGEN(b.x)]) == gen, bar);
            __builtin_amdgcn_fence(__ATOMIC_ACQUIRE, "agent");
            asm volatile("s_waitcnt vmcnt(0)" ::: "memory");
        }
    }
    __syncthreads();
}

__device__ __forceinline__ void tr_item(const float* W, int ldw, int K, int k0, int n0, bf16_t* WT, int drow0, lptr scr, int lane) {
    f32x4 tv[8];
#pragma unroll
    for (int i = 0; i < 8; ++i) tv[i] = *(const f32x4*)(W + (size_t)(k0 + 8 * i + (lane >> 3)) * ldw + n0 + 4 * (lane & 7));
#pragma unroll
    for (int i = 0; i < 8; ++i) {
        const lptr d_ = scr + ((8 * i + (lane >> 3)) * 33 + 4 * (lane & 7)) * 4;
        lds_st<float>(d_, tv[i][0]); lds_st<float>(d_ + 4, tv[i][1]); lds_st<float>(d_ + 8, tv[i][2]); lds_st<float>(d_ + 12, tv[i][3]);
    }
    const int c = lane & 7;
#pragma unroll
    for (int j = 0; j < 4; ++j) {
        const int n = (lane >> 3) + 8 * j; const lptr s = scr + ((8 * c) * 33 + n) * 4;
        u32x4 o; o.x = cvt_pk(lds_ld<float>(s), lds_ld<float>(s + 33 * 4)); o.y = cvt_pk(lds_ld<float>(s + 2 * 33 * 4), lds_ld<float>(s + 3 * 33 * 4));
        o.z = cvt_pk(lds_ld<float>(s + 4 * 33 * 4), lds_ld<float>(s + 5 * 33 * 4)); o.w = cvt_pk(lds_ld<float>(s + 6 * 33 * 4), lds_ld<float>(s + 7 * 33 * 4));
        *(u32x4*)(WT + (size_t)(drow0 + n) * K + k0 + 8 * c) = o;
    }
}
__device__ __forceinline__ void prep_weights(lptr L, const Params& P, int l) {
    const int tid = otid(), lane = tid & 63, wave = tid >> 6;
    const int gw = blockIdx.x * 8 + wave, NGW = gridDim.x * 8;
    const lptr scr = L + wave * 8704;
    unsigned char* ws = P.ws;
#pragma unroll 1
    for (int mi = 0; mi < 14; ++mi) {
        const float* W; int K, N, mode = 0; bf16_t* WT;
        switch (mi) {
            case 0: W = P.in[4] + (size_t)l * DM * 2 * DFF; K = DM; N = 2 * DFF; WT = (bf16_t*)(ws + W_1A); mode = 1; break;
            case 1: W = P.in[5] + (size_t)l * DFF * DM; K = DFF; N = DM; WT = (bf16_t*)(ws + W_2A); break;
            case 2: W = P.in[6] + (size_t)l * DM * ZLD; K = DM; N = ZLD; WT = (bf16_t*)(ws + W_Z); break;
            case 3: W = P.in[18] + (size_t)l * DM * 3 * DM; K = DM; N = 3 * DM; WT = (bf16_t*)(ws + W_G); break;
            case 4: W = P.in[15] + (size_t)l * 512 * DM; K = 512; N = DM; WT = (bf16_t*)(ws + W_BR); break;
            case 5: W = P.in[16] + (size_t)l * 512 * DM; K = 512; N = DM; WT = (bf16_t*)(ws + W_BR) + 1 * DM * 512; break;
            case 6: W = P.in[17] + (size_t)l * 512 * DM; K = 512; N = DM; WT = (bf16_t*)(ws + W_BR) + 2 * DM * 512; break;
            case 7: W = P.in[20] + (size_t)l * DM * DM; K = DM; N = DM; WT = (bf16_t*)(ws + W_O); break;
            case 8: W = P.in[23] + (size_t)l * DM * 2 * DFF; K = DM; N = 2 * DFF; WT = (bf16_t*)(ws + W_1B); mode = 1; break;
            case 9: W = P.in[24] + (size_t)l * DFF * DM; K = DFF; N = DM; WT = (bf16_t*)(ws + W_2B); break;
            case 10: W = P.in[9] + (size_t)l * 2048 * 256; K = 2048; N = 256; WT = (bf16_t*)(ws + W_C1); break;
            case 11: W = P.in[11] + (size_t)l * 2048 * 256; K = 2048; N = 256; WT = (bf16_t*)(ws + W_C1) + 256 * 2048; break;
            case 12: W = P.in[10] + (size_t)l * 256 * 64; K = 256; N = 64; WT = (bf16_t*)(ws + W_C2); break;
            default: W = P.in[12] + (size_t)l * 256 * 64; K = 256; N = 64; WT = (bf16_t*)(ws + W_C2) + 64 * 256; break;
        }
        const int nblk = N / 32, nitems = (K / 64) * nblk;
        for (int it = gw; it < nitems; it += NGW) {
            const int kb = it / nblk, nb = it - kb * nblk, n0 = 32 * nb;
            int drow0 = n0;
            if (mode == 1) { const int up = n0 >= DFF, nn = up ? n0 - DFF : n0; drow0 = 256 * (nn >> 7) + (up ? 128 : 0) + (nn & 127); }
            tr_item(W, N, K, 64 * kb, n0, WT, drow0, scr, lane);
        }
    }
    if (blockIdx.x < 32) {
        const int src = blockIdx.x >> 4, part = (blockIdx.x & 15) * 2 + (tid >> 8), n = tid & 255;
        const float* pe = (src ? P.in[8] : P.in[7]) + (size_t)l * 2048; const float* w1 = (src ? P.in[11] : P.in[9]) + (size_t)l * 2048 * 256;
        float s = 0.f;
        for (int k = 64 * part; k < 64 * part + 64; ++k) s += pe[k] * w1[(size_t)k * 256 + n];
        ((float*)(ws + W_PEB))[(src * 32 + part) * 256 + n] = s;
    }
}
__device__ __forceinline__ void prep_x(const Params& P) {
    const size_t n4 = (size_t)M * DM / 4; const f32x4* xi = (const f32x4*)P.in[0]; f32x4* xo = (f32x4*)P.out; u32x2* xn = (u32x2*)(P.ws + WS_XN);
    for (size_t i = (size_t)obid() * NT + otid(); i < n4; i += (size_t)gridDim.x * NT) {
        const f32x4 v = xi[i]; xo[i] = v; u32x2 w; w.x = cvt_pk(v[0], v[1]); w.y = cvt_pk(v[2], v[3]); xn[i] = w;
    }
}
__device__ __forceinline__ void ln_pass(const Params& P, const float* g, const float* b, const bool write_x) {
    const int tid_ = otid(); const int lane = tid_ & 63, wave = tid_ >> 6;
    const int gw = blockIdx.x * 8 + wave, NGW = gridDim.x * 8;
    f32x4 gv[4], bv[4];
#pragma unroll
    for (int j = 0; j < 4; ++j) { gv[j] = ((const f32x4*)g)[lane + 64 * j]; bv[j] = ((const f32x4*)b)[lane + 64 * j]; }
    float* stats = (float*)(P.ws + WS_STATS);
    for (int r0 = gw * 4; r0 < M; r0 += NGW * 4) {
        f32x4 v[4][4];
#pragma unroll
        for (int q = 0; q < 4; ++q) {
            const f32x4* xr = (const f32x4*)(P.out + (size_t)(r0 + q) * DM) + lane;
#pragma unroll
            for (int j = 0; j < 4; ++j) v[q][j] = xr[64 * j];
        }
#pragma unroll
        for (int q = 0; q < 4; ++q) {
            float s = 0.f;
#pragma unroll
            for (int j = 0; j < 4; ++j) s += (v[q][j][0] + v[q][j][1]) + (v[q][j][2] + v[q][j][3]);
            const float mean = wave_sum(s) * (1.f / DM); float s2 = 0.f;
#pragma unroll
            for (int j = 0; j < 4; ++j) { v[q][j] = v[q][j] - mean; s2 += (v[q][j][0] * v[q][j][0] + v[q][j][1] * v[q][j][1]) + (v[q][j][2] * v[q][j][2] + v[q][j][3] * v[q][j][3]); }
            const float rstd = 1.f / sqrtf(wave_sum(s2) * (1.f / DM) + LN_EPS);
            if (lane == 0) { float2 st; st.x = mean; st.y = rstd; *(float2*)(stats + 2 * (size_t)(r0 + q)) = st; }
            f32x4* xw = (f32x4*)(P.out + (size_t)(r0 + q) * DM) + lane;
            u32x2* o8 = (u32x2*)((bf16_t*)(P.ws + WS_XN) + (size_t)(r0 + q) * DM) + lane;
#pragma unroll
            for (int j = 0; j < 4; ++j) {
                const f32x4 y = v[q][j] * rstd * gv[j] + bv[j];
                if (write_x) xw[64 * j] = y;
                u32x2 w; w.x = cvt_pk(y[0], y[1]); w.y = cvt_pk(y[2], y[3]); o8[64 * j] = w;
            }
        }
    }
}
__device__ __forceinline__ float gelu_tanh(float x) {
    const float u = 0.7978845608028654f * (x + 0.044715f * x * x * x);
    const float t = ex2(2.f * LOG2E * u);
    return 0.5f * x * (2.f - 2.f * __builtin_amdgcn_rcpf(t + 1.f));
}
__device__ __forceinline__ float log_sigmoid(float x) { return x >= 0.f ? -log1pf(__expf(-x)) : x - log1pf(__expf(x)); }
__device__ __forceinline__ void compress_phase(lptr L, const Params& P, int l) {
    const int tid = otid(), lane = tid & 63, wave = tid >> 6, n = lane & 31, hl = lane >> 5;
    unsigned char* ws = P.ws; const bf16_t* Z = (const bf16_t*)(ws + WS_BIG);
    constexpr int HP = 264;
    for (int u = blockIdx.x; u < 256; u += gridDim.x) {
        const int src = u >> 7, bg = (u >> 3) & 15, rt = u & 7, b = bg >> 1, g = bg & 1, i0 = 32 * rt;
        const int coff = (src ? C_VCMP : C_KCMP) + g * 64;
        const bf16_t* Zb = Z + (size_t)b * SEQ * ZLD + coff + 8 * hl;
        const bf16_t* B1 = (const bf16_t*)(ws + W_C1) + (size_t)src * 256 * 2048 + (size_t)(32 * wave + n) * 2048 + 8 * hl;
        f32x16 acc = {};
        const int tok0 = 16 * (i0 + n);
#pragma unroll 2
        for (int p = 0; p < 32; ++p) {
            int tok = tok0 + p; tok = tok > SEQ - 1 ? SEQ - 1 : tok;
            const bf16_t* ar = Zb + (size_t)tok * ZLD; const bf16_t* br = B1 + p * 64;
#pragma unroll
            for (int s = 0; s < 4; ++s) acc = mfma32(*(const bf16x8*)(ar + 16 * s), *(const bf16x8*)(br + 16 * s), acc);
        }
        float peb = 0.f;
        { const float* pp = (const float*)(ws + W_PEB) + src * 32 * 256 + 32 * wave + n;
#pragma unroll 8
          for (int q = 0; q < 32; ++q) peb += pp[q * 256]; }
#pragma unroll
        for (int r = 0; r < 16; ++r) {
            const int row = 8 * (r >> 2) + 4 * hl + (r & 3);
            const float hv = gelu_tanh(acc[r] + peb);
            lds_st<bf16_t>(L + (row * HP + 32 * wave + n) * 2, (bf16_t)(cvt_pk(hv, 0.f) & 0xffffu));
        }
        __syncthreads();
        if (wave < 2) {
            const bf16_t* B2 = (const bf16_t*)(ws + W_C2) + (size_t)src * 64 * 256 + (size_t)(32 * wave + n) * 256 + 8 * hl;
            f32x16 a2 = {};
#pragma unroll
            for (int s = 0; s < 16; ++s) a2 = mfma32(lds_ld<bf16x8>(L + (n * HP + 16 * s + 8 * hl) * 2), *(const bf16x8*)(B2 + 16 * s), a2);
            bf16_t* out = (bf16_t*)(ws + WS_KC) + ((size_t)(src * 16 + bg) * 256 + i0) * 64 + 32 * wave + n;
#pragma unroll
            for (int r = 0; r < 16; ++r) {
                const int row = 8 * (r >> 2) + 4 * hl + (r & 3);
                const float v = (i0 + row < 255) ? a2[r] : 0.f;
                out[(size_t)row * 64] = (bf16_t)(cvt_pk(v, 0.f) & 0xffffu);
            }
        }
        __syncthreads();
    }
    for (int seq = blockIdx.x; seq < 64; seq += gridDim.x) {
        const int b = seq >> 3, h = seq & 7;
        const bf16_t* fz = Z + (size_t)b * SEQ * ZLD + C_FC + h + (size_t)(8 * tid) * ZLD; const float bf = P.in[14][l * 8 + h];
        float v[8];
#pragma unroll
        for (int i = 0; i < 8; ++i) v[i] = bf2f(fz[(size_t)i * ZLD]);
#pragma unroll
        for (int i = 0; i < 8; ++i) v[i] = log_sigmoid(v[i] + bf);
#pragma unroll
        for (int i = 1; i < 8; ++i) v[i] += v[i - 1];
        const float tot = v[7]; float inc = tot;
#pragma unroll
        for (int o = 1; o < 64; o <<= 1) { const float u_ = __shfl_up(inc, o); if (lane >= o) inc += u_; }
        if (lane == 63) lds_st<float>(L + wave * 4, inc);
        __syncthreads();
        float base = 0.f;
        for (int w = 0; w < wave; ++w) base += lds_ld<float>(L + w * 4);
        const float excl = base + inc - tot;
        f32x4 o0, o1;
#pragma unroll
        for (int i = 0; i < 4; ++i) { o0[i] = -(excl + v[i]) * LOG2E; o1[i] = -(excl + v[4 + i]) * LOG2E; }
        f32x4* cp = (f32x4*)((float*)(ws + WS_CUM) + (size_t)seq * SEQ + 8 * tid);
        cp[0] = o0; cp[1] = o1;
        __syncthreads();
    }
}
constexpr float SC2 = 0.125f * LOG2E, RESC_THR = 12.f;
#ifndef STAG_FOX
#define STAG_FOX false
#endif
#ifndef STAG_NSA
#define STAG_NSA false
#endif
#ifndef STAG_SWA
#define STAG_SWA false
#endif
enum { MODE_FOX = 0, MODE_WIN = 1, MODE_SEL = 2, MODE_CMP1 = 3, MODE_CMP2 = 4 };
struct AttnIO { const bf16_t* K; const bf16_t* V; int pitch; int maxrow; const float* cg; };
typedef short v4i16_t __attribute__((ext_vector_type(4)));
__device__ __forceinline__ s16x4 tr16(lptr p) { return __builtin_bit_cast(s16x4, __builtin_amdgcn_ds_read_tr16_b64_v4i16((LAS v4i16_t*)p)); }

__device__ __forceinline__ float half_max(float x) { auto rr = __builtin_amdgcn_permlane32_swap(__float_as_uint(x), __float_as_uint(x), false, false); return fmaxf(__uint_as_float(rr[0]), __uint_as_float(rr[1])); }
__device__ __forceinline__ float half_sum(float x) { auto rr = __builtin_amdgcn_permlane32_swap(__float_as_uint(x), __float_as_uint(x), false, false); return __uint_as_float(rr[0]) + __uint_as_float(rr[1]); }
__device__ __forceinline__ float half_other(float x, int hl) { auto rr = __builtin_amdgcn_permlane32_swap(__float_as_uint(x), __float_as_uint(x), false, false); return hl ? __uint_as_float(rr[0]) : __uint_as_float(rr[1]); }
__device__ __forceinline__ float max3f(float a, float b, float c) { float r; asm("v_max3_f32 %0, %1, %2, %3" : "=v"(r) : "v"(a), "v"(b), "v"(c)); return r; }
constexpr int TABP = 392, TAB0 = 128;
template <int MODE>
__device__ __forceinline__ void attn_tile(lptr L, const int buf, const int vcur, const int kt, const bf16x8 (&qf)[4], const int t, const int wtmin, const int wtmax,
                                          const int tabofs, const int W, const unsigned mlo, const unsigned mhi, float& m, float& l, f32x16 (&o)[2],
                                          const float mfix, const float linv, const int score_ofs, float& carry, const float tab128, const int lane, f32x16& negm) {
    const int n = lane & 31, hl = lane >> 5, q4 = (lane & 15) >> 2, p4 = lane & 3, blk = (lane >> 4) & 1;
    bool active = true;
    if (MODE == MODE_FOX) active = (64 * kt <= wtmax);
    const bool selbit = (MODE == MODE_SEL) ? ((((kt < 32) ? (mlo >> kt) : (mhi >> (kt - 32))) & 1u) != 0u) : true;
    if (MODE == MODE_SEL) active = __any(selbit) != 0;
    if (active) {
        const lptr Kt = L + A_KT + buf * 9216, Vt = L + A_VT + vcur * 12288;
        f32x16 s0, s1;
#pragma unroll
        for (int s4 = 0; s4 < 4; ++s4) {
            const bf16x8 a0 = lds_ld<bf16x8>(Kt + n * KP + s4 * 32 + hl * 16);
            const bf16x8 a1 = lds_ld<bf16x8>(Kt + (32 + n) * KP + s4 * 32 + hl * 16);
            if (s4 == 0) { s0 = mfma32(a0, qf[0], negm); s1 = mfma32(a1, qf[0], negm); }
            else { s0 = mfma32(a0, qf[s4], s0); s1 = mfma32(a1, qf[s4], s1); }
        }
        const int kbase = 64 * kt + 4 * hl;
        const bool far = (MODE == MODE_WIN || MODE == MODE_SEL) ? (wtmin - (64 * kt + 63) >= 128) : false;
        const bool fmask = (MODE == MODE_FOX) ? (64 * kt + 63 > wtmin) : false;
        const bool clean = (MODE == MODE_WIN) ? (far && (wtmax - 64 * kt < W)) : false;
        const float mref = (MODE == MODE_CMP2) ? mfix : ((m == -INFINITY) ? 0.f : m);
        if (MODE == MODE_FOX) {
#pragma unroll
            for (int kb = 0; kb < 2; ++kb)
#pragma unroll
                for (int a = 0; a < 4; ++a) {
                    const f32x4 c4 = lds_ld<f32x4>(L + A_CB + buf * 256 + (32 * kb + 8 * a + 4 * hl) * 4);
#pragma unroll
                    for (int e = 0; e < 4; ++e) { const int r = 4 * a + e; if (kb) s1[r] = s1[r] * SC2 + c4[e]; else s0[r] = s0[r] * SC2 + c4[e]; }
                }
            if (__builtin_amdgcn_readfirstlane((int)fmask)) {
#pragma unroll
                for (int r = 0; r < 16; ++r) {
                    const int key = kbase + 8 * (r >> 2) + (r & 3);
                    if (key > t) s0[r] = -INFINITY;
                    if (key + 32 > t) s1[r] = -INFINITY;
                }
            }
        } else if (clean || (MODE == MODE_SEL && far)) {
            const float add = (MODE == MODE_SEL && !selbit) ? -INFINITY : tab128;
#pragma unroll
            for (int r = 0; r < 16; ++r) { s0[r] = s0[r] * SC2 + add; s1[r] = s1[r] * SC2 + add; }
        } else if (MODE == MODE_WIN || MODE == MODE_SEL) {
            const int dbase = t - kbase;
            const lptr tb = L + tabofs + (dbase + TAB0 - 63) * 4;
#pragma unroll
            for (int kb = 0; kb < 2; ++kb)
#pragma unroll
                for (int a = 0; a < 4; ++a)
#pragma unroll
                    for (int e = 0; e < 4; ++e) {
                        const int r = 4 * a + e, off = 32 * kb + 8 * a + e; const int d = dbase - off;
                        const float bsv = far ? tab128 : lds_ld<float>(tb + 4 * (63 - off));
                        const bool ok = (MODE == MODE_WIN) ? ((unsigned)d < (unsigned)W) : (selbit && d >= 0);
                        const float sv = kb ? s1[r] : s0[r];
                        const float x = ok ? sv * SC2 + bsv : -INFINITY;
                        if (kb) s1[r] = x; else s0[r] = x;
                    }
        } else if (wtmin - (16 * (64 * kt + 63) + 31) >= 128) {
#pragma unroll
            for (int r = 0; r < 16; ++r) { s0[r] = s0[r] * SC2 + tab128; s1[r] = s1[r] * SC2 + tab128; }
        } else {
#pragma unroll
            for (int kb = 0; kb < 2; ++kb)
#pragma unroll
                for (int a = 0; a < 4; ++a)
#pragma unroll
                    for (int e = 0; e < 4; ++e) {
                        const int r = 4 * a + e; const int key = kbase + 32 * kb + 8 * a + e; const int d = t - (16 * key + 31);
                        int di = d < 0 ? 0 : d; di = di > 128 ? 128 : di;
                        const float bsv = lds_ld<float>(L + tabofs + (di + TAB0) * 4);
                        const float sv = kb ? s1[r] : s0[r];
                        const float x = (d >= 0) ? sv * SC2 + bsv : -INFINITY;
                        if (kb) s1[r] = x; else s0[r] = x;
                    }
        }
        if (MODE != MODE_CMP2) {
            float mx = max3f(s0[0], s1[0], s0[1]);
#pragma unroll
            for (int r = 1; r < 15; r += 2) { mx = max3f(mx, s1[r], s0[r + 1]); mx = max3f(mx, s1[r + 1], (r + 2 < 16) ? s0[r + 2] : s1[r + 1]); }
            mx = fmaxf(mx, s1[15]);
            mx = half_max(mx);
            const bool minf = (m == -INFINITY);
            if (__any((mx > RESC_THR) || (minf && mx > -INFINITY))) {
                const float delta = minf ? ((mx == -INFINITY) ? 0.f : mx) : fmaxf(mx, 0.f);
                m = (minf && mx == -INFINITY) ? -INFINITY : mref + delta;
                { const float nm = (m == -INFINITY) ? 0.f : -m * (1.0f / SC2);
#pragma unroll
                  for (int r = 0; r < 16; ++r) negm[r] = nm; }
                const float alpha = minf ? 1.f : ex2(-delta);
                l *= alpha;
                if (MODE != MODE_CMP1) { o[0] = o[0] * alpha; o[1] = o[1] * alpha; }
#pragma unroll
                for (int r = 0; r < 16; ++r) { s0[r] -= delta; s1[r] -= delta; }
            }
            float ps = 0.f;
#pragma unroll
            for (int r = 0; r < 16; ++r) { s0[r] = ex2(s0[r]); s1[r] = ex2(s1[r]); ps += s0[r] + s1[r]; }
            l += ps;
        } else {
#pragma unroll
            for (int r = 0; r < 16; ++r) { s0[r] = ex2(s0[r]) * linv; s1[r] = ex2(s1[r]) * linv; }
            float quad[8], last[8], recv[8];
#pragma unroll
            for (int a = 0; a < 4; ++a) {
                quad[a] = (s0[4 * a] + s0[4 * a + 1]) + (s0[4 * a + 2] + s0[4 * a + 3]); last[a] = s0[4 * a + 3];
                quad[4 + a] = (s1[4 * a] + s1[4 * a + 1]) + (s1[4 * a + 2] + s1[4 * a + 3]); last[4 + a] = s1[4 * a + 3];
            }
#pragma unroll
            for (int i = 0; i < 8; ++i) recv[i] = half_other(last[i], hl);
#pragma unroll
            for (int i = 0; i < 8; ++i) {
                const float prev = (i > 0) ? recv[i > 0 ? i - 1 : 0] : carry;
                float v = quad[i] + (hl ? recv[i] : prev);
                v += __shfl_xor(v, 1); v += __shfl_xor(v, 2);
                if ((n & 3) == 0) lds_st<float>(L + score_ofs + (16 * kt + 2 * i + hl) * 4, v);
            }
            carry = recv[7];
        }
        if (MODE != MODE_CMP1) {
            bf16x8 pf[4];
#pragma unroll
            for (int ks = 0; ks < 4; ++ks) {
                const int hb = 8 * (ks & 1); u32x4 w;
                if (ks >> 1) { w.x = cvt_pk(s1[hb], s1[hb + 1]); w.y = cvt_pk(s1[hb + 2], s1[hb + 3]); w.z = cvt_pk(s1[hb + 4], s1[hb + 5]); w.w = cvt_pk(s1[hb + 6], s1[hb + 7]); }
                else { w.x = cvt_pk(s0[hb], s0[hb + 1]); w.y = cvt_pk(s0[hb + 2], s0[hb + 3]); w.z = cvt_pk(s0[hb + 4], s0[hb + 5]); w.w = cvt_pk(s0[hb + 6], s0[hb + 7]); }
                pf[ks] = __builtin_bit_cast(bf16x8, w);
            }
            const lptr vb_ = Vt + (4 * hl + q4) * VP + 32 * blk + 8 * p4;
#pragma unroll
            for (int c_ = 0; c_ < 2; ++c_)
#pragma unroll
                for (int ks_ = 0; ks_ < 4; ++ks_) {
                    const s16x4 lo_ = tr16(vb_ + (16 * ks_) * VP + 64 * c_), hi_ = tr16(vb_ + (16 * ks_ + 8) * VP + 64 * c_);
                    const bf16x8 vf_ = {lo_[0], lo_[1], lo_[2], lo_[3], hi_[0], hi_[1], hi_[2], hi_[3]};
                    o[c_] = mfma32(vf_, pf[ks_], o[c_]);
                }
        }
    }
}
template <int MODE, bool PRE>
__device__ __forceinline__ void attn_loop(lptr L, const AttnIO io, const unsigned long long umask, const bf16x8 (&qf)[4], const int t, const int wtmin, const int wtmax,
                                          const int tabofs, const int W, const unsigned mlo, const unsigned mhi, float& m, float& l, f32x16 (&o)[2],
                                          const float mfix, const float linv, const int score_ofs, const u32x4 pk = u32x4{}, const u32x4 pv = u32x4{}) {
    const int tid = otid(), lane = tid & 63;
    const int srow = tid >> 3, sch = tid & 7;
    if (umask == 0ull) return;
    int kt = __builtin_ctzll(umask); unsigned long long rem = umask & (umask - 1ull);
    u32x4 kA, vA, kB, vB; float cA = 0.f, cB = 0.f;
#define STAGE_LOAD(KT, KR, VR, CR) do { int gr_ = 64 * (KT) + srow; gr_ = gr_ > io.maxrow ? io.maxrow : gr_; const size_t off_ = (size_t)gr_ * io.pitch + sch * 8; \
        KR = *(const u32x4*)(io.K + off_); VR = *(const u32x4*)(io.V + off_); if (MODE == MODE_FOX) { if (tid < 64) CR = io.cg[64 * (KT) + tid]; } } while (0)
#define STAGE_STORE(B, VB, KR, VR, CR) do { lds_st<u32x4>(L + A_KT + (B) * 9216 + srow * KP + sch * 16, KR); lds_st<u32x4>(L + A_VT + (VB) * 12288 + srow * VP + sch * 16, VR); \
        if (MODE == MODE_FOX) { if (tid < 64) lds_st<float>(L + A_CB + (B) * 256 + tid * 4, CR); } } while (0)
#define NEXT_TILE(X) do { X = rem ? __builtin_ctzll(rem) : -1; rem &= rem - 1ull; } while (0)
    if (PRE) { kA = pk; vA = pv; } else { STAGE_LOAD(kt, kA, vA, cA); }
    STAGE_STORE(0, 0, kA, vA, cA);
    int nk, nnk; NEXT_TILE(nk);
    if (nk >= 0) STAGE_LOAD(nk, kA, vA, cA);
    __syncthreads();
    int buf = 0, vcur = 0, vnext = 1; float carry = 0.f;
    const float tab128 = (MODE == MODE_FOX) ? 0.f : lds_ld<float>(L + tabofs + (128 + TAB0) * 4);
    f32x16 negm;
    { const float nm0 = (MODE == MODE_CMP2) ? -mfix * (1.0f / SC2) : ((m == -INFINITY) ? 0.f : -m * (1.0f / SC2));
#pragma unroll
      for (int r = 0; r < 16; ++r) negm[r] = nm0; }
    for (;;) {
        NEXT_TILE(nnk);
        if (nnk >= 0) STAGE_LOAD(nnk, kB, vB, cB);
        attn_tile<MODE>(L, buf, vcur, kt, qf, t, wtmin, wtmax, tabofs, W, mlo, mhi, m, l, o, mfix, linv, score_ofs, carry, tab128, lane, negm);
        if (nk >= 0) STAGE_STORE(buf ^ 1, vnext, kA, vA, cA);
        __syncthreads();
        if (nk < 0) break;
        kt = nk; nk = nnk; buf ^= 1; vcur = vnext; vnext ^= 1;
        NEXT_TILE(nnk);
        if (nnk >= 0) STAGE_LOAD(nnk, kA, vA, cA);
        attn_tile<MODE>(L, buf, vcur, kt, qf, t, wtmin, wtmax, tabofs, W, mlo, mhi, m, l, o, mfix, linv, score_ofs, carry, tab128, lane, negm);
        if (nk >= 0) STAGE_STORE(buf ^ 1, vnext, kB, vB, cB);
        __syncthreads();
        if (nk < 0) break;
        kt = nk; nk = nnk; buf ^= 1; vcur = vnext; vnext ^= 1;
    }
#undef STAGE_LOAD
#undef STAGE_STORE
#undef NEXT_TILE
}
__device__ __forceinline__ void first_tile_load(const AttnIO io, const int kt, u32x4& pk, u32x4& pv) {
    const int tid = otid(), srow = tid >> 3, sch = tid & 7;
    int gr = 64 * kt + srow; gr = gr > io.maxrow ? io.maxrow : gr;
    const size_t off = (size_t)gr * io.pitch + sch * 8;
    pk = *(const u32x4*)(io.K + off); pv = *(const u32x4*)(io.V + off);
}
__device__ __forceinline__ unsigned long long tile_bits(int lo, int hi) {
    const unsigned long long up = (hi >= 63) ? ~0ull : ((1ull << (hi + 1)) - 1ull);
    return up & ~((1ull << lo) - 1ull);
}
__device__ __forceinline__ void store_o(bf16_t* orow, const f32x16 (&o)[2], float sc, int hl) {
#pragma unroll
    for (int c = 0; c < 2; ++c)
#pragma unroll
        for (int a = 0; a < 4; ++a) {
            u32x2 w; w.x = cvt_pk(o[c][4 * a] * sc, o[c][4 * a + 1] * sc); w.y = cvt_pk(o[c][4 * a + 2] * sc, o[c][4 * a + 3] * sc);
            *(u32x2*)(orow + 32 * c + 8 * a + 4 * hl) = w;
        }
}
__device__ __forceinline__ void stash_put(lptr st, int lane, const f32x16 (&o)[2], float sc) {
#pragma unroll
    for (int c = 0; c < 2; ++c)
#pragma unroll
        for (int a = 0; a < 4; ++a) {
            u32x2 w; w.x = cvt_pk(o[c][4 * a] * sc, o[c][4 * a + 1] * sc); w.y = cvt_pk(o[c][4 * a + 2] * sc, o[c][4 * a + 3] * sc);
            lds_st<u32x2>(st + ((c * 4 + a) * 64 + lane) * 8, w);
        }
}
__device__ __forceinline__ void stash_add(lptr st, int lane, f32x16 (&o)[2], float sc) {
#pragma unroll
    for (int c = 0; c < 2; ++c)
#pragma unroll
        for (int a = 0; a < 4; ++a) {
            const u32x2 w = lds_ld<u32x2>(st + ((c * 4 + a) * 64 + lane) * 8);
            o[c][4 * a] = o[c][4 * a] * sc + __uint_as_float(w.x << 16); o[c][4 * a + 1] = o[c][4 * a + 1] * sc + __uint_as_float(w.x & 0xffff0000u);
            o[c][4 * a + 2] = o[c][4 * a + 2] * sc + __uint_as_float(w.y << 16); o[c][4 * a + 3] = o[c][4 * a + 3] * sc + __uint_as_float(w.y & 0xffff0000u);
        }
}
__device__ __forceinline__ void store_o_rows(lptr st, int lane, const f32x16 (&o)[2], float sc, bf16_t* gbase, const int gq) {
    const int n = lane & 31, hl = lane >> 5;
#pragma unroll
    for (int c = 0; c < 2; ++c)
#pragma unroll
        for (int a = 0; a < 4; ++a) {
            u32x2 w; w.x = cvt_pk(o[c][4 * a] * sc, o[c][4 * a + 1] * sc); w.y = cvt_pk(o[c][4 * a + 2] * sc, o[c][4 * a + 3] * sc);
            lds_st<u32x2>(st + n * 128 + (((4 * c + a) ^ (n & 7)) * 16) + 8 * hl, w);
        }
#pragma unroll
    for (int i = 0; i < 4; ++i) {
        const int col = i * 8 + (lane >> 3), ch = lane & 7;
        const u32x4 v = lds_ld<u32x4>(st + col * 128 + ((ch ^ (col & 7)) * 16));
        bf16_t* g = gbase + (gq ? ((col >> 2) * 512 + (col & 3) * 64) : col * 512) + ch * 8;
        *(u32x4*)g = v;
    }
}
__device__ __forceinline__ void fox_unit(lptr L, const Params& P, int b, int h, int qb) {
    const int tid_ = otid(); const int lane = tid_ & 63, wave = tid_ >> 6, n = lane & 31, hl = lane >> 5;
    const bf16_t* Zb = (const bf16_t*)(P.ws + WS_BIG) + (size_t)b * SEQ * ZLD;
    const int wtmin = qb * 256 + 32 * wave, t = wtmin + n;
    bf16x8 qf[4];
    { const bf16_t* qrow = Zb + (size_t)t * ZLD + C_QC + h * 64 + 8 * hl;
#pragma unroll
      for (int s = 0; s < 4; ++s) qf[s] = *(const bf16x8*)(qrow + 16 * s); }
    const AttnIO io{Zb + C_KC + h * 64, Zb + C_VC + h * 64, ZLD, SEQ - 1, (const float*)(P.ws + WS_CUM) + (size_t)(b * 8 + h) * SEQ};
    float m = -INFINITY, l = 0.f; f32x16 o[2] = {};
    attn_loop<MODE_FOX, false>(L, io, tile_bits(0, 4 * qb + 3), qf, t, wtmin, wtmin + 31, 0, 0, 0u, 0u, m, l, o, 0.f, 0.f, 0);
    const float lt = half_sum(l);
    store_o_rows(L + A_STASH + wave * 4096, lane, o, lt > 0.f ? 1.f / lt : 0.f, (bf16_t*)(P.ws + WS_OC) + (size_t)(b * SEQ + wtmin) * 512 + h * 64, 0);
}
__device__ __forceinline__ void swa_unit(lptr L, const Params& P, int layer, int b, int g, int qi) {
    const int tid_ = otid(); const int lane = tid_ & 63, wave = tid_ >> 6, n = lane & 31, hl = lane >> 5;
    const bf16_t* Zb = (const bf16_t*)(P.ws + WS_BIG) + (size_t)b * SEQ * ZLD;
    const int wtmin = 64 * qi + 8 * wave, t = wtmin + (n >> 2), head = g * 4 + (n & 3);
    bf16x8 qf[4];
    { const bf16_t* qrow = Zb + (size_t)t * ZLD + C_QB + head * 64 + 8 * hl;
#pragma unroll
      for (int s = 0; s < 4; ++s) qf[s] = *(const bf16x8*)(qrow + 16 * s); }
    const AttnIO io{Zb + C_KB + g * 64, Zb + C_VB + g * 64, ZLD, SEQ - 1, nullptr};
    float m = -INFINITY, l = 0.f; f32x16 o[2] = {};
    attn_loop<MODE_WIN, false>(L, io, tile_bits(qi >= 2 ? qi - 2 : 0, qi), qf, t, wtmin, wtmin + 7, A_TAB + (8 + head) * TABP * 4, 128, 0u, 0u, m, l, o, 0.f, 0.f, 0);
    const float lt = half_sum(l);
    const float sink = P.in[13][layer * 8 + head] * LOG2E;
    const float mm = fmaxf(m, sink), f = ex2(m - mm), den = lt * f + ex2(sink - mm);
    store_o_rows(L + A_STASH + wave * 4096, lane, o, f / den, (bf16_t*)(P.ws + WS_OB) + (size_t)(b * SEQ + wtmin) * 512 + g * 256, 1);
}
__device__ __forceinline__ void nsa_unit(lptr L, const Params& P, int b, int g, int qi) {
    const int tid = otid(), lane = tid & 63, wave = tid >> 6, n = lane & 31, hl = lane >> 5;
    const bf16_t* Zb = (const bf16_t*)(P.ws + WS_BIG) + (size_t)b * SEQ * ZLD;
    const int wtmin = 64 * qi + 8 * wave, ql = n >> 2, t = wtmin + ql, head = g * 4 + (n & 3);
    const int tabofs = A_TAB + head * TABP * 4;
    bf16x8 qf[4];
    { const bf16_t* qrow = Zb + (size_t)t * ZLD + C_QA + head * 64 + 8 * hl;
#pragma unroll
      for (int s = 0; s < 4; ++s) qf[s] = *(const bf16x8*)(qrow + 16 * s); }
    float gc, gs, gwn;
    { const bf16_t* gp = Zb + (size_t)t * ZLD + C_GA + head * 3; gc = sigmoidf_(bf2f(gp[0])); gs = sigmoidf_(bf2f(gp[1])); gwn = sigmoidf_(bf2f(gp[2])); }
    const lptr stash = L + A_STASH + wave * 4096;
    const AttnIO ioC{(const bf16_t*)(P.ws + WS_KC) + (size_t)(0 * 16 + b * 2 + g) * 256 * 64, (const bf16_t*)(P.ws + WS_KC) + (size_t)(1 * 16 + b * 2 + g) * 256 * 64, 64, 255, nullptr};
    const AttnIO ioS{Zb + C_KSLC + g * 64, Zb + C_VSLC + g * 64, ZLD, SEQ - 1, nullptr};
    const AttnIO ioW{Zb + C_KWIN + g * 64, Zb + C_VWIN + g * 64, ZLD, SEQ - 1, nullptr};
    const int wlo = qi >= 8 ? qi - 8 : 0;
    u32x4 pkn, pvn;
    {
        const unsigned long long um = tile_bits(0, (4 * qi + 2) >> 6);
        float m = -INFINITY, l = 0.f; f32x16 o[2] = {};
        first_tile_load(ioC, 0, pkn, pvn);
        attn_loop<MODE_CMP1, false>(L, ioC, um, qf, t, wtmin, wtmin + 7, tabofs, 0, 0u, 0u, m, l, o, 0.f, 0.f, 0);
        const float lt = half_sum(l);
        const float linv = lt > 0.f ? 1.f / lt : 0.f, mfix = (m == -INFINITY) ? 0.f : m;
#pragma unroll
        for (int i = 0; i < 8; ++i) lds_st<float>(L + A_SCORE + wave * 2048 + (i * 64 + lane) * 4, 0.f);
        const u32x4 pk2 = pkn, pv2 = pvn;
        first_tile_load(ioS, 0, pkn, pvn);
        attn_loop<MODE_CMP2, true>(L, ioC, um, qf, t, wtmin, wtmin + 7, tabofs, 0, 0u, 0u, m, l, o, mfix, linv, A_SCORE + wave * 2048 + ql * 256, pk2, pv2);
        stash_put(stash, lane, o, gc);
    }
#pragma unroll 1
    for (int q = 0; q < 8; ++q) {
        const int tq = wtmin + q, cur = tq >> 6, J = lane;
        const bool elig = (J >= 1) && (J <= cur - 2);
        float v = lds_ld<float>(L + A_SCORE + wave * 2048 + (q * 64 + lane) * 4);
        v = elig ? v : -INFINITY;
        const int nfree = 8 - (cur == 0 ? 1 : (cur == 1 ? 2 : 3));
        unsigned long long picked = 0ull;
#pragma unroll 1
        for (int it = 0; it < nfree; ++it) {
            const float vv = ((picked >> J) & 1ull) ? -INFINITY : v;
            float mxv = vv;
#pragma unroll
            for (int o_ = 1; o_ < 32; o_ <<= 1) mxv = fmaxf(mxv, __shfl_xor(mxv, o_));
            mxv = half_max(mxv);
            const unsigned long long cand = __ballot(vv == mxv && vv > -INFINITY);
            if (cand == 0ull) break;
            picked |= 1ull << __builtin_ctzll(cand);
        }
        const bool sel = (((picked >> J) & 1ull) != 0ull) || (J == 0) || (J == cur) || (J == cur - 1);
        const unsigned long long bm = __ballot(sel);
        if (lane == 0) { lds_st<unsigned>(L + A_SELM + (wave * 8 + q) * 8, (unsigned)bm); lds_st<unsigned>(L + A_SELM + (wave * 8 + q) * 8 + 4, (unsigned)(bm >> 32)); }
    }
    __syncthreads();
    unsigned ulo = lds_ld<unsigned>(L + A_SELM + lane * 8), uhi = lds_ld<unsigned>(L + A_SELM + lane * 8 + 4);
#pragma unroll
    for (int o_ = 1; o_ < 64; o_ <<= 1) { ulo |= (unsigned)__shfl_xor((int)ulo, o_); uhi |= (unsigned)__shfl_xor((int)uhi, o_); }
    ulo = __builtin_amdgcn_readfirstlane(ulo); uhi = __builtin_amdgcn_readfirstlane(uhi);
    const unsigned mlo = lds_ld<unsigned>(L + A_SELM + (wave * 8 + ql) * 8), mhi = lds_ld<unsigned>(L + A_SELM + (wave * 8 + ql) * 8 + 4);
    {
        float m = -INFINITY, l = 0.f; f32x16 o[2] = {};
        const u32x4 pk3 = pkn, pv3 = pvn;
        first_tile_load(ioW, wlo, pkn, pvn);
        attn_loop<MODE_SEL, true>(L, ioS, ((unsigned long long)uhi << 32) | ulo, qf, t, wtmin, wtmin + 7, tabofs, 0, mlo, mhi, m, l, o, 0.f, 0.f, 0, pk3, pv3);
        const float lt = half_sum(l); const float sc = (lt > 0.f ? 1.f / lt : 0.f) * gs;
        stash_add(stash, lane, o, sc); stash_put(stash, lane, o, 1.f);
    }
    {
        float m = -INFINITY, l = 0.f; f32x16 o[2] = {};
        attn_loop<MODE_WIN, true>(L, ioW, tile_bits(wlo, qi), qf, t, wtmin, wtmin + 7, tabofs, 512, 0u, 0u, m, l, o, 0.f, 0.f, 0, pkn, pvn);
        const float lt = half_sum(l); const float sc = (lt > 0.f ? 1.f / lt : 0.f) * gwn;
        stash_add(stash, lane, o, sc);
        store_o_rows(stash, lane, o, 1.f, (bf16_t*)(P.ws + WS_OA) + (size_t)(b * SEQ + wtmin) * 512 + g * 256, 1);
    }
}
__device__ __forceinline__ void attn_phase(lptr L, const Params& P, int layer) {
    const int tid = otid(), G = gridDim.x;
    const int blk = (G % 8 == 0) ? (int)(blockIdx.x % 8) * (G / 8) + (int)(blockIdx.x / 8) : (int)blockIdx.x;
    for (int i = tid; i < 16 * TABP; i += NT) {
        const int h = i / TABP, d = i - h * TABP - TAB0;
        float v = 0.f;
        if (d >= 0) {
            int bk = d;
            if (d >= 16) { bk = (d >= 128) ? 31 : 16 + (int)(logf((float)d * (1.f / 16.f)) / logf(8.f) * 16.f); bk = bk > 31 ? 31 : bk; }
            v = P.in[1][bk * 16 + h] * LOG2E;
        }
        lds_st<float>(L + A_TAB + i * 4, v);
    }
    __syncthreads();
#pragma unroll 1
    for (int p = blk; p < 512; p += G) {
#pragma unroll 1
        for (int j = 0; j < 2; ++j) {
#ifdef DBG_NO_FOX
            continue;
#endif
            const int bh = p >> 3, s = p & 7; fox_unit(L, P, bh >> 3, bh & 7, j ? 15 - s : s);
#ifdef PROBE_FOX2
            fox_unit(L, P, bh >> 3, bh & 7, j ? 15 - s : s);
#endif
        }
    }
#pragma unroll 1
    for (int p = blk; p < 512; p += G) {
#pragma unroll 1
        for (int j = 0; j < 2; ++j) {
#ifdef DBG_NO_NSA
            continue;
#endif
            const int bg = p >> 5, s = p & 31;
#ifdef PROBE_NSA2
            for (int rep_ = 0; rep_ < 2; ++rep_)
#endif
            nsa_unit(L, P, bg >> 1, bg & 1, j ? 63 - s : s); }
    }
#pragma unroll 1
    for (int u = blk; u < 1024; u += G) {
#ifdef DBG_NO_SWA
        continue;
#endif
        const int bg = u >> 6; swa_unit(L, P, layer, bg >> 1, bg & 1, u & 63); }
}
__global__ void __launch_bounds__(NT, 2) mk_fwd(Params P) {
    __shared__ __attribute__((aligned(16))) unsigned char lds_raw[LDS_BYTES];
    const lptr L = (lptr)lds_raw;
    cg::grid_group grid = cg::this_grid();
    unsigned char* ws = P.ws;
    bf16_t* XN = (bf16_t*)(ws + WS_XN); bf16_t* BIG = (bf16_t*)(ws + WS_BIG);
    const int G = gridDim.x;
    if (otid() < 4) lds_st<unsigned>(L + A_XB + otid() * 4, 0u);
    __syncthreads();
    XcdBarrier xbar = xcd_barrier_post((unsigned*)(ws + WS_BAR), (volatile LAS unsigned*)(L + A_XB));
    prep_x(P);
#pragma unroll 1
    for (int l = 0; l < DEPTH; ++l) {
#pragma unroll 1
        for (int si = 0; si < 14; ++si) {
            const int st = (si <= 7) ? si : (si == 8 ? 13 : si - 1);
            const int bx = obid();
#ifdef DBG_SKIP_LO
            if (st >= DBG_SKIP_LO && st <= DBG_SKIP_HI) continue;
#endif
            if (st == 0) {
                prep_weights(L, P, l);
#ifdef PROBE_PREP2
                __syncthreads(); prep_weights(L, P, l);
#endif
            } else if (st == 1 || st == 10) {
                pg8::Gemm g{XN, (const bf16_t*)(ws + (st == 1 ? W_1A : W_1B)), M, 2 * DFF, DM}; pg8::StaticOrder S; S.init(M, 2 * DFF, G, bx);
                EpiSwiGLU E{BIG};
                pg8::gemm_phase<EpiSwiGLU, pg8::StaticOrder, true, true>((PG8_LAS unsigned char*)L, g, S, E);
#ifdef PROBE_UP2
                pg8::gemm_phase<EpiSwiGLU, pg8::StaticOrder, true, true>((PG8_LAS unsigned char*)L, g, S, E);
#endif
            } else if (st == 2 || st == 11 || st == 8) {
                const bf16_t* A = (st == 8) ? (const bf16_t*)(ws + WS_MRG) : BIG;
                const bf16_t* Bt = (const bf16_t*)(ws + (st == 8 ? W_O : (st == 2 ? W_2A : W_2B)));
                pg8::Gemm g{A, Bt, M, DM, st == 8 ? DM : DFF}; pg8::StaticOrder S; S.init(M, DM, G, bx);
                const float* eg = (st == 2) ? (l ? P.in[25] + (l - 1) * DM : nullptr) : (st == 8 ? P.in[2] + l * DM : P.in[21] + l * DM);
                const float* eb = (st == 2) ? (l ? P.in[26] + (l - 1) * DM : nullptr) : (st == 8 ? P.in[3] + l * DM : P.in[22] + l * DM);
                EpiResid E{P.out, (const float*)(ws + WS_STATS), eg, eb, ALPHA, st == 8 ? 1.0f : 0.5f};
                pg8::gemm_phase<EpiResid, pg8::StaticOrder, true, true>((PG8_LAS unsigned char*)L, g, S, E);
#ifdef PROBE_RESID2
                { EpiResid E2{P.out, (const float*)(ws + WS_STATS), nullptr, nullptr, 1.0f, 0.0f};
                  pg8::gemm_phase<EpiResid, pg8::StaticOrder, true, true>((PG8_LAS unsigned char*)L, g, S, E2); }
#endif
            } else if (st == 3 || st == 9 || st == 12) {
                const float* lg = st == 3 ? P.in[2] : (st == 9 ? P.in[21] : P.in[25]); const float* lb = st == 3 ? P.in[3] : (st == 9 ? P.in[22] : P.in[26]);
                ln_pass(P, lg + l * DM, lb + l * DM, l == DEPTH - 1 && st == 12);
            } else if (st == 4) {
                pg8::Gemm g{XN, (const bf16_t*)(ws + W_Z), M, 3840, DM}; pg8::StaticOrder S; S.init(M, 3840, G, bx);
                EpiZ E{BIG};
                pg8::gemm_phase<EpiZ, pg8::StaticOrder, true, true>((PG8_LAS unsigned char*)L, g, S, E);
#ifdef PROBE_Z2
                pg8::gemm_phase<EpiZ, pg8::StaticOrder, true, true>((PG8_LAS unsigned char*)L, g, S, E);
#endif
            } else if (st == 5) {
                compress_phase(L, P, l);
#ifdef PROBE_CMP2
                __syncthreads(); compress_phase(L, P, l);
#endif
            } else if (st == 6) {
                attn_phase(L, P, l);
#ifdef PROBE_ATTN2
                __syncthreads(); attn_phase(L, P, l);
#endif
            } else if (st == 7) {
                pg8::Gemm g{XN, (const bf16_t*)(ws + W_G), M, 3 * DM, DM}; pg8::StaticOrder S; S.init(M, 3 * DM, G, bx);
                EpiGate E{(bf16_t*)(ws + WS_GATE), P.in[19] + (size_t)l * 3 * DM};
                pg8::gemm_phase<EpiGate, pg8::StaticOrder, true, true>((PG8_LAS unsigned char*)L, g, S, E);
#ifdef PROBE_GATE2
                pg8::gemm_phase<EpiGate, pg8::StaticOrder, true, true>((PG8_LAS unsigned char*)L, g, S, E);
#endif
            } else if (st == 13) {
                pg8::Gemm g{(const bf16_t*)(ws + WS_OA), (const bf16_t*)(ws + W_BR), 3 * M, 3 * DM, 512}; MergeOrder S; S.base.init(M, DM, G, bx);
                EpiMerge E{(const bf16_t*)(ws + WS_GATE), (bf16_t*)(ws + WS_MRG)};
                pg8::gemm_phase<EpiMerge, MergeOrder, true, true>((PG8_LAS unsigned char*)L, g, S, E);
            }
            if (l == 0 && st == 0) grid.sync();
            xcd_barrier(xbar);
#ifdef PROBE_XB2
            xcd_barrier(xbar); xcd_barrier(xbar);
#endif
        }
    }
}
}

extern "C" void kernel_launch(void* const* d_in, const int* in_sizes, int n_in, void* d_out, int out_size, void* d_ws, size_t ws_size, hipStream_t stream) {
    static int grid = 0;
    if (grid == 0) {
        if (n_in != 27 || out_size != mk::M * mk::DM || ws_size < mk::WS_TOTAL) { fprintf(stderr, "kernel_launch: unexpected shapes (n_in %d, out %d, ws %zu)\n", n_in, out_size, ws_size); grid = -1; return; }
        int dev = 0, cus = 0, per_cu = 0;
        hipGetDevice(&dev); hipDeviceGetAttribute(&cus, hipDeviceAttributeMultiprocessorCount, dev);
        hipOccupancyMaxActiveBlocksPerMultiprocessor(&per_cu, (const void*)mk::mk_fwd, mk::NT, 0);
        if (per_cu < 1) { fprintf(stderr, "kernel_launch: occupancy query says %d blocks/CU\n", per_cu); per_cu = 1; }
        grid = cus * 1;
    }
    if (grid < 0) return;
    if (hipMemsetAsync((char*)d_ws + mk::WS_BAR, 0, 16384, stream) != hipSuccess) { fprintf(stderr, "memset failed\n"); return; }
    mk::Params p{};
    for (int i = 0; i < 27; ++i) p.in[i] = (const float*)d_in[i];
    p.out = (float*)d_out; p.ws = (unsigned char*)d_ws;
    void* args[] = {&p};
    hipError_t e = hipLaunchCooperativeKernel((const void*)mk::mk_fwd, dim3(grid), dim3(mk::NT), args, 0, stream);
    if (e != hipSuccess) fprintf(stderr, "cooperative launch failed: %s (grid %d)\n", hipGetErrorString(e), grid);
}
```
